# Optimizing an MI355X kernel written in HIP

```python
import jax, jax.numpy as jnp
from jax import lax
import numpy as np

D_MODEL = 2048
BATCH = 4
SEQ = 4096
DEPTH = 2

N_A_LAYERS = DEPTH // 2
N_B_LAYERS = DEPTH - N_A_LAYERS
N_DENSE = (DEPTH + 1) // 2
N_MOE = DEPTH // 2

POOL_WINDOWS = (2, 4, 8, 16)
N_POOL_GROUPS = 4
POOL_GROUP_DIM = D_MODEL // N_POOL_GROUPS

HEAD_DIM = 128
N_HEADS = D_MODEL // HEAD_DIM
MOBA_BLOCK = 256
MOBA_TOPK = 3
MOBA_QCHUNK = 16
ROPE_THETA = 10000.0

D_FF = ((8 * D_MODEL // 3 + 255) // 256) * 256
N_EXPERTS = 8
MOE_TOPK = 2
D_FF_EXPERT = 7 * D_MODEL // 2
MOE_BLOCK = 512

DEEPNORM_ALPHA = (2.0 * DEPTH) ** 0.25
DEEPNORM_BETA = (8.0 * DEPTH) ** -0.25
LN_EPS = 1e-5
NEG = -1e30

kernel_name = 'yoco_pool_moba_moe_deepnorm'


def layer_norm(x, g, b):
    xf = x.astype(jnp.float32)
    mu = jnp.mean(xf, axis=-1, keepdims=True)
    var = jnp.mean(jnp.square(xf - mu), axis=-1, keepdims=True)
    y = (xf - mu) * lax.rsqrt(var + LN_EPS)
    return (y * g.astype(jnp.float32) + b.astype(jnp.float32)).astype(x.dtype)


def pool_mixer(x, w_groups, scale):
    B, S, D = x.shape
    xg = x.reshape(B, S, N_POOL_GROUPS, POOL_GROUP_DIM)
    csum = jnp.cumsum(xg.astype(jnp.float32), axis=1)
    t = jnp.arange(S)
    pooled = []
    for g, w in enumerate(POOL_WINDOWS):
        c = csum[:, :, g]
        lag = jnp.pad(c[:, :S - w], ((0, 0), (w, 0), (0, 0)))
        cnt = jnp.minimum(t + 1, w).astype(jnp.float32)[None, :, None]
        pooled.append((c - lag) / cnt)
    pooled = jnp.stack(pooled, axis=2)
    diff = (pooled - xg.astype(jnp.float32)).astype(x.dtype)
    y = jnp.einsum('bsgc,gcd->bsgd', diff, w_groups)
    return y.reshape(B, S, D) * scale


def rope_tables(S):
    inv = 1.0 / (ROPE_THETA ** (jnp.arange(0, HEAD_DIM, 2, dtype=jnp.float32) / HEAD_DIM))
    ang = jnp.arange(S, dtype=jnp.float32)[:, None] * inv[None, :]
    ang = jnp.concatenate([ang, ang], axis=-1)
    return jnp.cos(ang), jnp.sin(ang)


def apply_rope(t, cos, sin):
    tf = t.astype(jnp.float32)
    t1, t2 = jnp.split(tf, 2, axis=-1)
    rot = jnp.concatenate([-t2, t1], axis=-1)
    return (tf * cos + rot * sin).astype(t.dtype)


def split_heads(t):
    B, S, _ = t.shape
    return t.reshape(B, S, N_HEADS, HEAD_DIM).transpose(0, 2, 1, 3)


def shared_kv(h, w_kv, cos, sin):
    B, S, D = h.shape
    k, v = jnp.split(h @ w_kv, 2, axis=-1)
    k = apply_rope(split_heads(k), cos, sin)
    v = split_heads(v)
    nb = -(-S // MOBA_BLOCK)
    pad = nb * MOBA_BLOCK - S
    k = jnp.pad(k, ((0, 0), (0, 0), (0, pad), (0, 0)))
    v = jnp.pad(v, ((0, 0), (0, 0), (0, pad), (0, 0)))
    k_blocks = k.reshape(B, N_HEADS, nb, MOBA_BLOCK, HEAD_DIM)
    v_blocks = v.reshape(B, N_HEADS, nb, MOBA_BLOCK, HEAD_DIM)
    k_mean = jnp.mean(k_blocks.astype(jnp.float32), axis=3).astype(k.dtype)
    return k_blocks, v_blocks, k_mean


def moba_attention(x, w_q, w_o, k_blocks, v_blocks, k_mean, cos, sin):
    B, S, D = x.shape
    nb = k_blocks.shape[2]
    topk = min(MOBA_TOPK, nb)
    q = apply_rope(split_heads(x @ w_q), cos, sin)
    gate = jnp.einsum('bhsd,bhnd->bhsn', q, k_mean).astype(jnp.float32)
    q_blk = jnp.arange(S) // MOBA_BLOCK
    past = jnp.arange(nb)[None, :] < q_blk[:, None]
    gate = jnp.where(past, gate, NEG)
    _, sel = lax.top_k(gate, topk)
    scale = HEAD_DIM ** -0.5
    gather = jax.vmap(jax.vmap(lambda blocks, ix: blocks[ix]))
    sel_len = topk * MOBA_BLOCK

    def chunk(i):
        c0 = i * MOBA_QCHUNK
        qc = lax.dynamic_slice_in_dim(q, c0, MOBA_QCHUNK, axis=2)
        ic = lax.dynamic_slice_in_dim(sel, c0, MOBA_QCHUNK, axis=2)
        own = c0 // MOBA_BLOCK
        k_sel = gather(k_blocks, ic)
        v_sel = gather(v_blocks, ic)
        k_own = lax.dynamic_index_in_dim(k_blocks, own, axis=2, keepdims=False)
        v_own = lax.dynamic_index_in_dim(v_blocks, own, axis=2, keepdims=False)
        s_sel = jnp.einsum('bhqd,bhqjkd->bhqjk', qc, k_sel).astype(jnp.float32) * scale
        s_own = jnp.einsum('bhqd,bhkd->bhqk', qc, k_own).astype(jnp.float32) * scale
        qpos = c0 + jnp.arange(MOBA_QCHUNK)
        kpos = own * MOBA_BLOCK + jnp.arange(MOBA_BLOCK)
        s_own = jnp.where(kpos[None, :] <= qpos[:, None], s_own, NEG)
        slot_ok = jnp.arange(topk) < own
        s_sel = jnp.where(slot_ok[:, None], s_sel, NEG)
        s = jnp.concatenate([s_sel.reshape(B, N_HEADS, MOBA_QCHUNK, sel_len), s_own], axis=-1)
        p = jax.nn.softmax(s, axis=-1).astype(x.dtype)
        p_sel = p[..., :sel_len].reshape(B, N_HEADS, MOBA_QCHUNK, topk, MOBA_BLOCK)
        p_own = p[..., sel_len:]
        return (jnp.einsum('bhqjk,bhqjkd->bhqd', p_sel, v_sel)
                + jnp.einsum('bhqk,bhkd->bhqd', p_own, v_own))

    o = lax.map(chunk, jnp.arange(S // MOBA_QCHUNK))
    o = o.transpose(1, 0, 3, 2, 4).reshape(B, S, D)
    return o @ w_o


def swiglu(x, w_gate, w_up, w_down):
    return (jax.nn.silu(x @ w_gate) * (x @ w_up)) @ w_down


def moe_ffn(x, w_router, w_gate, w_up, w_down):
    B, S, D = x.shape
    T = B * S
    xf = x.reshape(T, D)
    logits = (xf @ w_router).astype(jnp.float32)
    top_logit, top_e = lax.top_k(logits, MOE_TOPK)
    gates = jax.nn.softmax(top_logit, axis=-1)
    a_exp = top_e.reshape(-1)
    a_tok = jnp.repeat(jnp.arange(T, dtype=jnp.int32), MOE_TOPK)
    a_gate = gates.reshape(-1)
    order = jnp.argsort(a_exp)
    s_exp, s_tok, s_gate = a_exp[order], a_tok[order], a_gate[order]
    counts = jnp.zeros((N_EXPERTS,), jnp.int32).at[a_exp].add(1)
    starts = jnp.cumsum(counts) - counts
    p_counts = (counts + MOE_BLOCK - 1) // MOE_BLOCK * MOE_BLOCK
    p_ends = jnp.cumsum(p_counts)
    p_starts = p_ends - p_counts
    n_assign = MOE_TOPK * T
    dest = p_starts[s_exp] + jnp.arange(n_assign, dtype=jnp.int32) - starts[s_exp]
    n_blocks = -(-n_assign // MOE_BLOCK) + N_EXPERTS
    P = n_blocks * MOE_BLOCK
    buf_tok = jnp.zeros((P,), jnp.int32).at[dest].set(s_tok)
    buf_gate = jnp.zeros((P,), jnp.float32).at[dest].set(s_gate)
    blk_start = jnp.arange(n_blocks, dtype=jnp.int32) * MOE_BLOCK
    blk_exp = jnp.minimum(jnp.searchsorted(p_ends, blk_start, side='right'), N_EXPERTS - 1)

    def expert_block(args):
        e, toks = args
        xb = xf[toks]
        return (jax.nn.silu(xb @ w_gate[e]) * (xb @ w_up[e])) @ w_down[e]

    out = lax.map(expert_block, (blk_exp, buf_tok.reshape(n_blocks, MOE_BLOCK)))
    out = out.reshape(P, D) * buf_gate[:, None].astype(x.dtype)
    y = jnp.zeros((T, D), x.dtype).at[buf_tok].add(out)
    return y.reshape(B, S, D)


def setup_inputs(seed: int = 0) -> dict:
    key = jax.random.key(seed)
    ks = jax.random.split(key, 20)
    f32 = jnp.float32
    n = lambda k, shp, s: jax.random.normal(k, shp, f32) * s
    D = D_MODEL
    w_k = n(ks[3], (D, D), D ** -0.5)
    w_v = n(ks[4], (D, D), D ** -0.5 * DEEPNORM_BETA)
    return {
        'x': jax.random.normal(ks[0], (BATCH, SEQ, D), f32),
        'pool_w': n(ks[1], (N_A_LAYERS, N_POOL_GROUPS, POOL_GROUP_DIM, POOL_GROUP_DIM), POOL_GROUP_DIM ** -0.5 * DEEPNORM_BETA),
        'pool_scale': 1.0 + n(ks[2], (N_A_LAYERS, D), 0.02),
        'w_kv': jnp.concatenate([w_k, w_v], axis=1),
        'moba_wq': n(ks[5], (N_B_LAYERS, D, D), D ** -0.5),
        'moba_wo': n(ks[6], (N_B_LAYERS, D, D), D ** -0.5 * DEEPNORM_BETA),
        'ffn_w_gate': n(ks[7], (N_DENSE, D, D_FF), D ** -0.5),
        'ffn_w_up': n(ks[8], (N_DENSE, D, D_FF), D ** -0.5),
        'ffn_w_down': n(ks[9], (N_DENSE, D_FF, D), D_FF ** -0.5 * DEEPNORM_BETA),
        'moe_router': n(ks[10], (N_MOE, D, N_EXPERTS), D ** -0.5),
        'moe_w_gate': n(ks[11], (N_MOE, N_EXPERTS, D, D_FF_EXPERT), D ** -0.5),
        'moe_w_up': n(ks[12], (N_MOE, N_EXPERTS, D, D_FF_EXPERT), D ** -0.5),
        'moe_w_down': n(ks[13], (N_MOE, N_EXPERTS, D_FF_EXPERT, D), D_FF_EXPERT ** -0.5 * DEEPNORM_BETA),
        'ln_mix_g': 1.0 + n(ks[14], (DEPTH, D), 0.02),
        'ln_mix_b': n(ks[15], (DEPTH, D), 0.02),
        'ln_ffn_g': 1.0 + n(ks[16], (DEPTH, D), 0.02),
        'ln_ffn_b': n(ks[17], (DEPTH, D), 0.02),
    }


def reference(x, pool_w, pool_scale, w_kv, moba_wq, moba_wo, ffn_w_gate, ffn_w_up, ffn_w_down,
              moe_router, moe_w_gate, moe_w_up, moe_w_down, ln_mix_g, ln_mix_b, ln_ffn_g, ln_ffn_b):
    S = x.shape[1]
    cos, sin = rope_tables(S)
    kv = None
    for l in range(DEPTH):
        if l < N_A_LAYERS:
            mix = pool_mixer(x, pool_w[l], pool_scale[l])
        else:
            b = l - N_A_LAYERS
            k_blocks, v_blocks, k_mean = kv
            mix = moba_attention(x, moba_wq[b], moba_wo[b], k_blocks, v_blocks, k_mean, cos, sin)
        x = layer_norm(DEEPNORM_ALPHA * x + mix, ln_mix_g[l], ln_mix_b[l])
        if l % 2 == 0:
            j = l // 2
            f = swiglu(x, ffn_w_gate[j], ffn_w_up[j], ffn_w_down[j])
        else:
            j = l // 2
            f = moe_ffn(x, moe_router[j], moe_w_gate[j], moe_w_up[j], moe_w_down[j])
        x = layer_norm(DEEPNORM_ALPHA * x + f, ln_ffn_g[l], ln_ffn_b[l])
        if l == N_A_LAYERS - 1:
            kv = shared_kv(x, w_kv, cos, sin)
    return x
```

```cpp
#include <hip/hip_runtime.h>
#include <cstdio>
#include <cstdint>

#define LAS __attribute__((address_space(3)))
#define GAS __attribute__((address_space(1)))
typedef unsigned short bf16_t;
typedef short bf16x8 __attribute__((ext_vector_type(8)));
typedef short s16x4 __attribute__((ext_vector_type(4)));
typedef float f32x2 __attribute__((ext_vector_type(2)));
typedef float f32x4 __attribute__((ext_vector_type(4)));
typedef float f32x16 __attribute__((ext_vector_type(16)));
typedef unsigned u32x2 __attribute__((ext_vector_type(2)));
typedef unsigned u32x4 __attribute__((ext_vector_type(4)));
typedef int i32x4 __attribute__((ext_vector_type(4)));
typedef int i32x8 __attribute__((ext_vector_type(8)));
typedef signed char i8_t;

#ifndef PROBE_DUP
#define PROBE_DUP -1
#endif
#ifndef PROBE_RELAUNCH
#define PROBE_RELAUNCH -1
#endif
#ifndef MK_N_LAUNCHES
#define MK_N_LAUNCHES 1
#endif

constexpr int NB = 4, SEQ = 4096, DM = 2048, NH = 16, HD = 128, M = NB * SEQ;
constexpr int DFF = 5632, NE = 8, DFE = 7168, NBLK = SEQ / 256, PGC = 512;
constexpr float ALPHA = 1.4142135623730951f, LN_EPS = 1e-5f;
constexpr int PMAX = 2 * M + NE * 256;
constexpr int NWAVES = 8, NTHREADS = 512;

constexpr size_t MiB = 1u << 20;
constexpr size_t WS_CTL = 0, CTL_ZERO_BYTES = 1 * MiB;
constexpr size_t WS_COS = 1 * MiB, WS_SIN = 2 * MiB;
constexpr size_t WS_KMEAN = 3 * MiB;
constexpr size_t WS_SCL = 3 * MiB + 512 * 1024;
constexpr size_t WS_TOKE = 4 * MiB, WS_TOKG = WS_TOKE + 128 * 1024, WS_TOKR = WS_TOKG + 128 * 1024, WS_TOKP = WS_TOKR + 128 * 1024;
constexpr size_t WS_SWQKV = 5 * MiB, WS_SWGU = WS_SWQKV + 32 * 1024, WS_SX = WS_SWQKV + 96 * 1024, WS_SXS = WS_SWQKV + 160 * 1024, WS_SWM = WS_SWQKV + 512 * 1024;
constexpr size_t WS_SWD = WS_SWQKV + 960 * 1024;
constexpr size_t WS_WPOOL = 6 * MiB;
constexpr size_t WS_WQKV = 8 * MiB;
constexpr size_t WS_WO = 32 * MiB;
constexpr size_t WS_WGU = 40 * MiB;
constexpr size_t WS_WD = 84 * MiB;
constexpr size_t WS_MWGU = 106 * MiB;
constexpr size_t WS_MWD = 554 * MiB;
constexpr size_t WS_XF = 778 * MiB;
constexpr size_t WS_XB = 906 * MiB;
constexpr size_t WS_XS = 970 * MiB;
constexpr size_t WS_OE = 1106 * MiB;
constexpr size_t WS_A = 1242 * MiB;
constexpr size_t WS_DIFF = WS_A, WS_HFFN = WS_A + 64 * MiB, WS_Q = WS_A + 240 * MiB, WS_K = WS_A + 304 * MiB, WS_V = WS_A + 368 * MiB, WS_O = WS_A + 432 * MiB;
constexpr size_t WS_HMOE = WS_A;
constexpr size_t WS_END = 1738 * MiB;
static_assert((size_t)PMAX * DFE * 2 <= 496 * MiB && (size_t)PMAX * DM * 2 <= 136 * MiB, "ws map");
constexpr int CW_TMO = 0, CW_CODE = 1;
constexpr int CW_CNT = 64;
constexpr int CW_VMAX = 80;
constexpr int CW_BAR = 4096;
constexpr int CW_DONE = 65536;
constexpr int CW_CMAX = 16384;

constexpr int RING_OFF = 0, RING_BYTES = 131072;
constexpr int LDS_BYTES = 147456;
constexpr int LDSCTL_OFF = LDS_BYTES - 2048, MISC_OFF = LDSCTL_OFF + 320;
static_assert(75776 + 32 * 2064 + 1024 <= LDSCTL_OFF, "LDS map");
constexpr int SIDE_OFF = 75776;

#define RLX_AGENT __ATOMIC_RELAXED, __HIP_MEMORY_SCOPE_AGENT
#define LDS_WAIT() asm volatile("s_waitcnt lgkmcnt(0)" ::: "memory")
#define VM_WAIT() asm volatile("s_waitcnt vmcnt(0)" ::: "memory")

__device__ __forceinline__ unsigned cvt_pk_bf16(float lo, float hi) { unsigned r; asm volatile("v_cvt_pk_bf16_f32 %0, %1, %2" : "=v"(r) : "v"(lo), "v"(hi)); return r; }
__device__ __forceinline__ float bf2f(unsigned short b) { return __uint_as_float((unsigned)b << 16); }
__device__ __forceinline__ int lane_id() { int l; asm volatile("v_mbcnt_lo_u32_b32 %0, -1, 0\n\tv_mbcnt_hi_u32_b32 %0, -1, %0" : "=v"(l)); return l; }
__device__ __forceinline__ float wave_sum(float v) {
#pragma unroll
    for (int o = 1; o < 64; o <<= 1) v += __shfl_xor(v, o);
    return v;
}

__device__ __forceinline__ float quad_xor1(float v) { return __int_as_float(__builtin_amdgcn_update_dpp(0, __float_as_int(v), 0xB1, 0xf, 0xf, false)); }
__device__ __forceinline__ float quad_xor2(float v) { return __int_as_float(__builtin_amdgcn_update_dpp(0, __float_as_int(v), 0x4E, 0xf, 0xf, false)); }
__device__ __forceinline__ float wave_max(float v) {
#pragma unroll
    for (int o = 1; o < 64; o <<= 1) v = fmaxf(v, __shfl_xor(v, o));
    return v;
}
__device__ __forceinline__ unsigned pack_i8x4(float a, float b, float c, float d) {
    const unsigned ua = __float_as_uint(a + 12582912.f), ub = __float_as_uint(b + 12582912.f), uc = __float_as_uint(c + 12582912.f), ud = __float_as_uint(d + 12582912.f);
    return __builtin_amdgcn_perm(ub, ua, 0x0c0c0400u) | __builtin_amdgcn_perm(ud, uc, 0x04000c0cu);
}

#define XB_TMO      128
#define XB_XCNT(j)  (256  + 64 * (j))
#define XB_XSUB(j)  (1280 + 64 * (j))
#define XB_XGEN(j)  (2304 + 64 * (j))
#define XB_TOP      3328
#define XB_TOPGEN   3392
#define XCD_BAR_WORDS 3456
#define XB_SPIN_CAP (1u << 20)
__device__ __forceinline__ unsigned xb_ld(unsigned* p)              { return __hip_atomic_load(p, __ATOMIC_RELAXED, __HIP_MEMORY_SCOPE_AGENT); }
__device__ __forceinline__ unsigned xb_add(unsigned* p, unsigned v) { return __hip_atomic_fetch_add(p, v, __ATOMIC_RELAXED, __HIP_MEMORY_SCOPE_AGENT); }
__device__ __forceinline__ unsigned xb_xcc_id() { return (unsigned)__builtin_amdgcn_s_getreg((3 << 11) | 20) & 0xFu; }
#define XB_SPIN(cond, bar) do { unsigned _sp = 0; while (cond) { __builtin_amdgcn_s_sleep(1); \
    if ((++_sp & 255u) == 0u) { if (xb_ld(&(bar)[XB_TMO])) break; if (_sp > XB_SPIN_CAP) { atomicAdd(&(bar)[XB_TMO], 1u); break; } } } } while (0)
struct XcdBarrier { unsigned* bar; unsigned x; volatile LAS unsigned* st; };
__device__ __forceinline__ XcdBarrier xcd_barrier_post(unsigned* bar, volatile LAS unsigned* st, bool leader) {
    XcdBarrier b; b.bar = bar; b.x = xb_xcc_id(); b.st = st;
    if (leader) (void)xb_add(&bar[XB_XCNT(b.x)], 1u);
    return b;
}
__device__ __forceinline__ void xcd_barrier_complete(unsigned* bar, unsigned x, unsigned& nloc, unsigned& nx) {
    const unsigned G = gridDim.x * gridDim.y * gridDim.z;
    unsigned sum, cnt, mine, sp = 0u;
    for (;;) {
        sum = 0u; cnt = 0u; mine = 0u;
#pragma unroll
        for (unsigned j = 0; j < 16; ++j) { const unsigned c = xb_ld(&bar[XB_XCNT(j)]); sum += c; cnt += (c > 0u) ? 1u : 0u; mine = (j == x) ? c : mine; }
        if (sum == G) break;
        __builtin_amdgcn_s_sleep(1);
        if ((++sp & 255u) == 0u) { if (xb_ld(&bar[XB_TMO])) break; if (sp > XB_SPIN_CAP) { atomicAdd(&bar[XB_TMO], 1u); break; } }
    }
    nloc = mine > 0u ? mine : 1u; nx = cnt > 0u ? cnt : 1u;
}
__device__ __forceinline__ void xcd_barrier(const XcdBarrier& b, int wave) {
    asm volatile("s_waitcnt vmcnt(0)" ::: "memory");
    __syncthreads();
    if (wave == 0 && lane_id() == 0) {
        unsigned* bar = b.bar;
        __builtin_amdgcn_s_waitcnt(0);
        unsigned nloc = b.st[0], nx = b.st[1];
        if (nloc == 0u) { xcd_barrier_complete(bar, b.x, nloc, nx); b.st[0] = nloc; b.st[1] = nx; }
        const unsigned old = xb_add(&bar[XB_XSUB(b.x)], 1u);
        const unsigned gen = old / nloc;
        if (old + 1u == (gen + 1u) * nloc) {
            __builtin_amdgcn_fence(__ATOMIC_RELEASE, "agent");
            asm volatile("s_waitcnt vmcnt(0)" ::: "memory");
            const unsigned og = xb_add(&bar[XB_TOP], 1u);
            const unsigned tg = og / nx;
            if (og + 1u == (tg + 1u) * nx) xb_add(&bar[XB_TOPGEN], 1u);
            else XB_SPIN(xb_ld(&bar[XB_TOPGEN]) == tg, bar);
            __builtin_amdgcn_fence(__ATOMIC_ACQUIRE, "agent");
            xb_add(&bar[XB_XGEN(b.x)], 1u);
            asm volatile("s_waitcnt vmcnt(0)" ::: "memory");
        } else {
            XB_SPIN(xb_ld(&bar[XB_XGEN(b.x)]) == gen, bar);
            __builtin_amdgcn_fence(__ATOMIC_ACQUIRE, "agent");
            asm volatile("s_waitcnt vmcnt(0)" ::: "memory");
        }
    }
    __syncthreads();
}

namespace pg8 {
constexpr int BM = 256, BK = 64, HALF = 128, HTB = HALF * BK * 2, STAGE_BYTES = 8 * HTB, NXCD = 8;
#ifndef PG8_B_AUX
#define PG8_B_AUX 0
#endif
#ifndef WGM_BIGK
#define WGM_BIGK 4
#endif
#ifndef PG8_WGM
#define PG8_WGM 4
#endif
constexpr int WGM = PG8_WGM;
__host__ __device__ __forceinline__ int lds_byte(int r, int c) { const int st = (r >> 4) * 2 + (c >> 5), rr = r & 15, cc = c & 31, ob = rr * 64 + cc * 2; return st * 1024 + (ob ^ (((ob >> 9) & 1) << 5)); }
__host__ __device__ __forceinline__ void stage_rc(int b, int& R, int& C) { const int st = b / 1024, sb = b % 1024, swz = sb ^ (((sb >> 9) & 1) << 5); R = (st >> 1) * 16 + swz / 64; C = (st & 1) * 32 + (swz % 64) / 2; }
__host__ __device__ __forceinline__ int perm32(int rho) { const int n = rho >> 4, i = rho & 15; return 8 * (i >> 2) + 4 * n + (i & 3); }

__device__ __forceinline__ void glds16_s(const char* sbase, unsigned voff, unsigned lds_dst) {
    unsigned keep;
    asm volatile("s_mov_b32 %0, m0\n\ts_mov_b32 m0, %3\n\ts_nop 0\n\tglobal_load_lds_dwordx4 %1, %2\n\ts_mov_b32 m0, %0" : "=&s"(keep) : "v"(voff), "s"(sbase), "s"(lds_dst) : "memory");
}
struct Unit { const char* A; const char* B; int pm, pn, aux; };
struct GemmP { int nt; unsigned lda, ldb; };
template <int DT> struct AccOf { typedef f32x4 T; };
template <> struct AccOf<1> { typedef i32x4 T; };
__device__ __forceinline__ f32x4 tof(f32x4 v) { return v; }
__device__ __forceinline__ f32x4 tof(i32x4 v) { return __builtin_convertvector(v, f32x4); }

struct TileOrder {
    int nM, nN, nwg, G, c, wgm;
    __device__ __forceinline__ void init(int nM_, int nN_, int G_, int c_, int wgm_ = WGM) { nM = nM_; nN = nN_; nwg = nM * nN; G = G_; c = c_; wgm = wgm_; }
    __device__ __forceinline__ bool pmpn(int i, int& pm, int& pn) const {
        const long L = (long)i * G + c; if (L >= nwg) return false;
        int wgid = (int)L; { const int q = nwg / NXCD, r = nwg % NXCD, xcd = wgid % NXCD, off = wgid / NXCD; wgid = (xcd < r ? xcd * (q + 1) : r * (q + 1) + (xcd - r) * q) + off; }
        const int nig = wgm * nN, gid = wgid / nig, fm = gid * wgm, gsz = (nM - fm) < wgm ? (nM - fm) : wgm;
        pm = __builtin_amdgcn_readfirstlane(fm + ((wgid % nig) % gsz)); pn = __builtin_amdgcn_readfirstlane((wgid % nig) / gsz); return true;
    }
};

template <int DT, class Epi, class Sched, bool ALIGN_EPI>
__device__ __forceinline__ void gemm_phase(LAS unsigned char* lds, const GemmP g, const Sched& S, const Epi& E, const int wid) {
    typedef typename AccOf<DT>::T AccT;
    const int lane = lane_id(), tid = wid * 64 + lane, wr = wid >> 2, wc = wid & 3, fr = lane & 15, fq = lane >> 4;
    const int nt = g.nt;
    unsigned voffA[2], voffB[2];
#pragma unroll
    for (int i = 0; i < 2; ++i) { int R, C; stage_rc(tid * 16 + i * 8192, R, C); const int Rb = Epi::PERM ? ((R & ~31) + perm32(R & 31)) : R;
        voffA[i] = (unsigned)R * g.lda + (unsigned)C * 2u; voffB[i] = (unsigned)Rb * g.ldb + (unsigned)C * 2u; }
    const size_t kstep = (size_t)(BK * 2);
    const size_t hstepA = (size_t)HALF * g.lda, hstepB = (size_t)HALF * g.ldb;
    const unsigned ldsw = (unsigned)wid * 1024u;
    const unsigned ldsb = (unsigned)__builtin_amdgcn_readfirstlane((int)((unsigned)(uintptr_t)lds + (unsigned)wid * 1024u));
    const int aoff = lds_byte(wr * 64 + fr, fq * 8), boff = lds_byte(wc * 32 + fr, fq * 8);
#define PG8_SA(b, h) (((b) * 2 + (h)) * HTB)
#define PG8_SB(b, h) ((4 + (b) * 2 + (h)) * HTB)
#define PG8_STAGE_(bufoff, gbase, voff, AUX) do { _Pragma("unroll") for (int _i = 0; _i < 2; ++_i) { \
        if constexpr (DT == 2) glds16_s((const char*)(gbase), (voff)[_i], ldsb + (unsigned)((bufoff) + _i * 8192)); \
        else __builtin_amdgcn_global_load_lds((const unsigned*)((const char*)(gbase) + (voff)[_i]), (LAS unsigned*)(lds + (bufoff) + ldsw + _i * 8192), 16, 0, AUX); } } while (0)
#define PG8_STAGE(bufoff, gbase, voff) PG8_STAGE_(bufoff, gbase, voff, 0)
#define PG8_STAGEB(bufoff, gbase, voff) PG8_STAGE_(bufoff, gbase, voff, PG8_B_AUX)
#define PG8_LDA(dst, b, h) do { _Pragma("unroll") for (int m = 0; m < 4; ++m) _Pragma("unroll") for (int k = 0; k < 2; ++k) dst[m][k] = *(const LAS bf16x8*)(lds + PG8_SA(b, h) + aoff + m * 2048 + k * 1024); } while (0)
#define PG8_LDB(dst, b, h) do { _Pragma("unroll") for (int n = 0; n < 2; ++n) _Pragma("unroll") for (int k = 0; k < 2; ++k) dst[n][k] = *(const LAS bf16x8*)(lds + PG8_SB(b, h) + boff + n * 2048 + k * 1024); } while (0)
#define PG8_MMA(ai, bj, At, Bt) do { __builtin_amdgcn_s_setprio(1); _Pragma("unroll") for (int m = 0; m < 4; ++m) _Pragma("unroll") for (int n = 0; n < 2; ++n) { \
        if constexpr (DT == 0) { _Pragma("unroll") for (int k = 0; k < 2; ++k) acc[ai][bj][m][n] = __builtin_amdgcn_mfma_f32_16x16x32_bf16(Bt[n][k], At[m][k], acc[ai][bj][m][n], 0, 0, 0); } \
        else if constexpr (DT == 1) { _Pragma("unroll") for (int k = 0; k < 2; ++k) acc[ai][bj][m][n] = __builtin_amdgcn_mfma_i32_16x16x64_i8(__builtin_bit_cast(i32x4, Bt[n][k]), __builtin_bit_cast(i32x4, At[m][k]), acc[ai][bj][m][n], 0, 0, 0); } \
        else { const i32x4 b0_ = __builtin_bit_cast(i32x4, Bt[n][0]), b1_ = __builtin_bit_cast(i32x4, Bt[n][1]), a0_ = __builtin_bit_cast(i32x4, At[m][0]), a1_ = __builtin_bit_cast(i32x4, At[m][1]); \
            acc[ai][bj][m][n] = __builtin_amdgcn_mfma_scale_f32_16x16x128_f8f6f4((i32x8){b0_[0], b0_[1], b0_[2], b0_[3], b1_[0], b1_[1], b1_[2], b1_[3]}, (i32x8){a0_[0], a0_[1], a0_[2], a0_[3], a1_[0], a1_[1], a1_[2], a1_[3]}, acc[ai][bj][m][n], 0, 0, 0, 0, 0, 0); } } \
        __builtin_amdgcn_s_setprio(0); } while (0)
#define PG8_WAIT_V(n) asm volatile("s_waitcnt vmcnt(" #n ")" ::: "memory")
#define PG8_WAIT_L(n) asm volatile("s_waitcnt lgkmcnt(" #n ")" ::: "memory")
#define PG8_BAR __builtin_amdgcn_s_barrier()
#define PG8_SCHED __builtin_amdgcn_sched_barrier(0)
    Unit cur, nxt; int ui = 0;
    if (!S.next(0, cur)) return;
    AccT acc[2][2][4][2];
#pragma unroll
    for (int a = 0; a < 2; ++a)
#pragma unroll
        for (int b = 0; b < 2; ++b)
#pragma unroll
            for (int m = 0; m < 4; ++m)
#pragma unroll
                for (int n = 0; n < 2; ++n) acc[a][b][m][n] = (AccT){0, 0, 0, 0};
    bf16x8 At[4][2], B0[2][2], B1[2][2];
    const char* cA = cur.A; const char* cB = cur.B;
    PG8_STAGEB(PG8_SB(0, 0), cB, voffB); PG8_STAGEB(PG8_SB(0, 1), cB + hstepB, voffB); PG8_STAGE(PG8_SA(0, 0), cA, voffA); PG8_STAGE(PG8_SA(0, 1), cA + hstepA, voffA);
    if (wr == 1) PG8_BAR;
    PG8_WAIT_V(2); PG8_BAR;
    PG8_STAGEB(PG8_SB(1, 0), cB + kstep, voffB); PG8_STAGE(PG8_SA(1, 0), cA + kstep, voffA); PG8_STAGEB(PG8_SB(1, 1), cB + hstepB + kstep, voffB);
    PG8_WAIT_V(6); PG8_BAR;
    for (;;) {
        const bool has_next = S.next(ui + 1, nxt);
        const char* nA = has_next ? nxt.A : cA; const char* nB = has_next ? nxt.B : cB;
        for (int t = 0; t < nt; t += 2) {
            const bool last = (t == nt - 2);
            const char* a1 = cA + (size_t)(t + 1) * kstep;
            const char* a2 = last ? nA : cA + (size_t)(t + 2) * kstep; const char* b2 = last ? nB : cB + (size_t)(t + 2) * kstep;
            const char* a3 = a2 + kstep; const char* b3 = b2 + kstep;
            PG8_LDB(B0, 0, 0); PG8_LDB(B1, 0, 1); PG8_SCHED; PG8_LDA(At, 0, 0); PG8_STAGE(PG8_SA(1, 1), a1 + hstepA, voffA);
            PG8_WAIT_V(8); PG8_WAIT_L(0); PG8_BAR; PG8_MMA(0, 0, At, B0); PG8_MMA(0, 1, At, B1); PG8_BAR; PG8_SCHED;
            PG8_LDA(At, 0, 1); PG8_STAGEB(PG8_SB(0, 0), b2, voffB); PG8_STAGEB(PG8_SB(0, 1), b2 + hstepB, voffB); PG8_STAGE(PG8_SA(0, 0), a2, voffA);
            PG8_WAIT_V(8); PG8_WAIT_L(0); PG8_BAR; PG8_MMA(1, 0, At, B0); PG8_MMA(1, 1, At, B1); PG8_BAR; PG8_SCHED;
            PG8_LDB(B0, 1, 0); PG8_LDB(B1, 1, 1); PG8_SCHED; PG8_LDA(At, 1, 0); PG8_STAGE(PG8_SA(0, 1), a2 + hstepA, voffA);
            PG8_WAIT_V(8); PG8_WAIT_L(0); PG8_BAR; PG8_MMA(0, 0, At, B0); PG8_MMA(0, 1, At, B1); PG8_BAR; PG8_SCHED;
            PG8_LDA(At, 1, 1); PG8_STAGEB(PG8_SB(1, 0), b3, voffB); PG8_STAGEB(PG8_SB(1, 1), b3 + hstepB, voffB); PG8_STAGE(PG8_SA(1, 0), a3, voffA);
            PG8_WAIT_V(8); PG8_WAIT_L(0); PG8_BAR; PG8_MMA(1, 0, At, B0); PG8_MMA(1, 1, At, B1); PG8_BAR; PG8_SCHED;
        }
        if constexpr (ALIGN_EPI) { if (wr == 0) PG8_BAR; }
        { const int le = lane_id(); E(acc, cur, wr, wc, le & 15, le >> 4); }
        if (!has_next) break;
#pragma unroll
        for (int a = 0; a < 2; ++a)
#pragma unroll
            for (int b = 0; b < 2; ++b)
#pragma unroll
                for (int m = 0; m < 4; ++m)
#pragma unroll
                    for (int n = 0; n < 2; ++n) acc[a][b][m][n] = (AccT){0, 0, 0, 0};
        cur = nxt; cA = nA; cB = nB; ++ui;
        if constexpr (ALIGN_EPI) { if (wr == 1) PG8_BAR; }
    }
    PG8_WAIT_V(0);
    if constexpr (!ALIGN_EPI) { if (wr == 0) PG8_BAR; }
    PG8_BAR;
#undef PG8_SA
#undef PG8_SB
#undef PG8_STAGE
#undef PG8_STAGEB
#undef PG8_STAGE_
#undef PG8_LDA
#undef PG8_LDB
#undef PG8_MMA
#undef PG8_WAIT_V
#undef PG8_WAIT_L
#undef PG8_BAR
#undef PG8_SCHED
}

__device__ __forceinline__ void unpack_bf16x8(const u32x4 w, f32x4& a, f32x4& b) {
    a[0] = __uint_as_float(w.x << 16); a[1] = __uint_as_float(w.x & 0xffff0000u); a[2] = __uint_as_float(w.y << 16); a[3] = __uint_as_float(w.y & 0xffff0000u);
    b[0] = __uint_as_float(w.z << 16); b[1] = __uint_as_float(w.z & 0xffff0000u); b[2] = __uint_as_float(w.w << 16); b[3] = __uint_as_float(w.w & 0xffff0000u);
}
template <bool RES_F32> struct EpiRes {
    static constexpr bool PERM = true;
    const void* res; bf16_t* out; int ldc; const float* colscale; const float* scl;
    template <class AccT> __device__ __forceinline__ void operator()(const AccT (&acc)[2][2][4][2], const Unit& u, int wr, int wc, int fr, int fq) const {
        const int row0 = u.pm * BM + wr * 64 + fr, col0 = u.pn * BM + wc * 32 + 8 * fq;
        const float cinv = scl ? 1.0f / *scl : 1.0f;
        f32x4 cs[2][2];
#pragma unroll
        for (int bj = 0; bj < 2; ++bj)
#pragma unroll
            for (int n = 0; n < 2; ++n) cs[bj][n] = colscale ? *(const f32x4*)(colscale + col0 + bj * HALF + n * 4) * cinv : (f32x4){cinv, cinv, cinv, cinv};
#pragma unroll
        for (int ai = 0; ai < 2; ++ai)
#pragma unroll
            for (int m = 0; m < 4; ++m) { const size_t off = (size_t)(row0 + ai * HALF + m * 16) * ldc + col0;
#pragma unroll
                for (int bj = 0; bj < 2; ++bj) { f32x4 r0, r1;
                    if constexpr (RES_F32) { r0 = *(const f32x4*)((const float*)res + off + bj * HALF); r1 = *(const f32x4*)((const float*)res + off + bj * HALF + 4); }
                    else unpack_bf16x8(*(const u32x4*)((const bf16_t*)res + off + bj * HALF), r0, r1);
                    const f32x4 v0 = r0 * ALPHA + tof(acc[ai][bj][m][0]) * cs[bj][0], v1 = r1 * ALPHA + tof(acc[ai][bj][m][1]) * cs[bj][1];
                    u32x4 w; w.x = cvt_pk_bf16(v0[0], v0[1]); w.y = cvt_pk_bf16(v0[2], v0[3]); w.z = cvt_pk_bf16(v1[0], v1[1]); w.w = cvt_pk_bf16(v1[2], v1[3]);
                    *(u32x4*)(out + off + bj * HALF) = w; } }
    }
};
__device__ __forceinline__ float silu_mul(float g, float u) { return g * __builtin_amdgcn_rcpf(1.0f + __builtin_amdgcn_exp2f(-1.4426950408889634f * g)) * u; }
template <bool OUT8> struct EpiSwiGLU {
    static constexpr bool PERM = true;
    void* H; int ldh; const float* sx; const float* sw; int sw_estride;
    template <class AccT> __device__ __forceinline__ void operator()(const AccT (&acc)[2][2][4][2], const Unit& u, int wr, int wc, int fr, int fq) const {
        const int row0 = u.pm * BM + wr * 64 + fr, col0 = u.pn * HALF + wc * 32 + 8 * fq;
        const float* swp = sw + (size_t)u.aux * sw_estride + u.pn * BM + wc * 32 + 8 * fq;
        const f32x4 wg0 = *(const f32x4*)swp, wg1 = *(const f32x4*)(swp + 4), wu0 = *(const f32x4*)(swp + HALF), wu1 = *(const f32x4*)(swp + HALF + 4);
#pragma unroll
        for (int ai = 0; ai < 2; ++ai)
#pragma unroll
            for (int m = 0; m < 4; ++m) { const int r = row0 + ai * HALF + m * 16; const float sr = sx[r];
                const f32x4 g0 = tof(acc[ai][0][m][0]) * (wg0 * sr), g1 = tof(acc[ai][0][m][1]) * (wg1 * sr), u0 = tof(acc[ai][1][m][0]) * (wu0 * sr), u1 = tof(acc[ai][1][m][1]) * (wu1 * sr);
                f32x4 e0 = g0 * -1.4426950408889634f, e1 = g1 * -1.4426950408889634f;
#pragma unroll
                for (int i = 0; i < 4; ++i) { e0[i] = __builtin_amdgcn_exp2f(e0[i]); e1[i] = __builtin_amdgcn_exp2f(e1[i]); }
                e0 = e0 + 1.0f; e1 = e1 + 1.0f;
#pragma unroll
                for (int i = 0; i < 4; ++i) { e0[i] = __builtin_amdgcn_rcpf(e0[i]); e1[i] = __builtin_amdgcn_rcpf(e1[i]); }
                const f32x4 h0 = (g0 * u0) * e0, h1 = (g1 * u1) * e1;
                const float h[8] = {h0[0], h0[1], h0[2], h0[3], h1[0], h1[1], h1[2], h1[3]};
                if constexpr (OUT8) {
                    int p0 = __builtin_amdgcn_cvt_pk_fp8_f32(h[0], h[1], 0, false); p0 = __builtin_amdgcn_cvt_pk_fp8_f32(h[2], h[3], p0, true);
                    int p1 = __builtin_amdgcn_cvt_pk_fp8_f32(h[4], h[5], 0, false); p1 = __builtin_amdgcn_cvt_pk_fp8_f32(h[6], h[7], p1, true);
                    *(u32x2*)((unsigned char*)H + (size_t)r * ldh + col0) = (u32x2){(unsigned)p0, (unsigned)p1};
                } else {
                    u32x4 w; w.x = cvt_pk_bf16(h[0], h[1]); w.y = cvt_pk_bf16(h[2], h[3]); w.z = cvt_pk_bf16(h[4], h[5]); w.w = cvt_pk_bf16(h[6], h[7]);
                    *(u32x4*)((bf16_t*)H + (size_t)r * ldh + col0) = w; } }
    }
};
struct EpiBf16 {
    static constexpr bool PERM = true;
    bf16_t* O; int ldc; const float* scl;
    template <class AccT> __device__ __forceinline__ void operator()(const AccT (&acc)[2][2][4][2], const Unit& u, int wr, int wc, int fr, int fq) const {
        const int row0 = u.pm * BM + wr * 64 + fr, col0 = u.pn * BM + wc * 32 + 8 * fq;
        const float cinv = scl ? 1.0f / scl[u.aux] : 1.0f;
#pragma unroll
        for (int ai = 0; ai < 2; ++ai)
#pragma unroll
            for (int m = 0; m < 4; ++m) { bf16_t* rowp = O + (size_t)(row0 + ai * HALF + m * 16) * ldc + col0;
#pragma unroll
                for (int bj = 0; bj < 2; ++bj) { const f32x4 v0 = tof(acc[ai][bj][m][0]) * cinv, v1 = tof(acc[ai][bj][m][1]) * cinv;
                    u32x4 w; w.x = cvt_pk_bf16(v0[0], v0[1]); w.y = cvt_pk_bf16(v0[2], v0[3]); w.z = cvt_pk_bf16(v1[0], v1[1]); w.w = cvt_pk_bf16(v1[2], v1[3]);
                    *(u32x4*)(rowp + bj * HALF) = w; } }
    }
};
struct EpiQKV {
    static constexpr bool PERM = true;
    bf16_t* Q; bf16_t* Kd; bf16_t* V; const float* cs; const float* sn; const float* sx; const float* sw; unsigned* vmax;
    template <class AccT> __device__ __forceinline__ void operator()(const AccT (&acc)[2][2][4][2], const Unit& u, int wr, int wc, int fr, int fq) const {
        const int row0 = u.pm * BM + wr * 64 + fr;
        const float* swp = sw + u.pn * BM + wc * 32 + 8 * fq;
        const f32x4 w00 = *(const f32x4*)swp, w01 = *(const f32x4*)(swp + 4), w10 = *(const f32x4*)(swp + HALF), w11 = *(const f32x4*)(swp + HALF + 4);
        if (u.pn >= 16) {
            const int dcol = wc * 32 + 8 * fq;
            f32x4 vm = (f32x4){0.f, 0.f, 0.f, 0.f};
#pragma unroll
            for (int ai = 0; ai < 2; ++ai)
#pragma unroll
                for (int m = 0; m < 4; ++m) { const int r = row0 + ai * HALF + m * 16, b = r >> 12, s = r & (SEQ - 1); const float sr = sx[r];
#pragma unroll
                    for (int bj = 0; bj < 2; ++bj) { const int h = 2 * (u.pn - 16) + bj; const f32x4 v0 = tof(acc[ai][bj][m][0]) * ((bj ? w10 : w00) * sr), v1 = tof(acc[ai][bj][m][1]) * ((bj ? w11 : w01) * sr);
                        vm = __builtin_elementwise_max(vm, __builtin_elementwise_max(__builtin_elementwise_abs(v0), __builtin_elementwise_abs(v1)));
                        u32x4 w; w.x = cvt_pk_bf16(v0[0], v0[1]); w.y = cvt_pk_bf16(v0[2], v0[3]); w.z = cvt_pk_bf16(v1[0], v1[1]); w.w = cvt_pk_bf16(v1[2], v1[3]);
                        *(u32x4*)(V + ((size_t)(b * NH + h) * SEQ + s) * HD + dcol) = w; } }
            const float t = wave_max(fmaxf(fmaxf(vm[0], vm[1]), fmaxf(vm[2], vm[3])));
            if (lane_id() == 0) __hip_atomic_fetch_max(vmax, __float_as_uint(t), __ATOMIC_RELAXED, __HIP_MEMORY_SCOPE_AGENT);
        } else {
            bf16_t* dst = (u.pn >= 8) ? Kd : Q;
            const int h = 2 * (u.pn & 7) + (wc >> 1), dlo = (wc & 1) * 32 + 8 * fq;
#pragma unroll
            for (int ai = 0; ai < 2; ++ai)
#pragma unroll
                for (int m = 0; m < 4; ++m) { const int r = row0 + ai * HALF + m * 16, b = r >> 12, s = r & (SEQ - 1); const float sr = sx[r];
                    const f32x4 c0 = *(const f32x4*)(cs + s * 64 + dlo), c1 = *(const f32x4*)(cs + s * 64 + dlo + 4), s0 = *(const f32x4*)(sn + s * 64 + dlo), s1 = *(const f32x4*)(sn + s * 64 + dlo + 4);
                    const f32x4 l0 = tof(acc[ai][0][m][0]) * (w00 * sr), l1 = tof(acc[ai][0][m][1]) * (w01 * sr), h0 = tof(acc[ai][1][m][0]) * (w10 * sr), h1 = tof(acc[ai][1][m][1]) * (w11 * sr);
                    const f32x4 ol0 = l0 * c0 - h0 * s0, ol1 = l1 * c1 - h1 * s1, oh0 = h0 * c0 + l0 * s0, oh1 = h1 * c1 + l1 * s1;
                    bf16_t* p = dst + ((size_t)(b * NH + h) * SEQ + s) * HD + dlo;
                    u32x4 w; w.x = cvt_pk_bf16(ol0[0], ol0[1]); w.y = cvt_pk_bf16(ol0[2], ol0[3]); w.z = cvt_pk_bf16(ol1[0], ol1[1]); w.w = cvt_pk_bf16(ol1[2], ol1[3]);
                    *(u32x4*)p = w;
                    w.x = cvt_pk_bf16(oh0[0], oh0[1]); w.y = cvt_pk_bf16(oh0[2], oh0[3]); w.z = cvt_pk_bf16(oh1[0], oh1[1]); w.w = cvt_pk_bf16(oh1[2], oh1[3]);
                    *(u32x4*)(p + 64) = w; }
        }
    }
};
}

namespace att {
constexpr int D = 128, NW = 8, QBLK = 32, KVBLK = 64, QB = 256, LDO = DM;
constexpr float SCALE = 0.08838834764831845f;
constexpr int SHM_V = KVBLK * D * 2, SHM_K = KVBLK * D * 2;
constexpr int OFF_WS = 2 * SHM_V + 2 * SHM_K, OFF_KM = OFF_WS + NW * 64 * 4, LDS_BYTES = OFF_KM + 8192;
#define KSWZ(row, colB) ((row) * 256 + ((colB) ^ (((row) & 7) << 4)))
#define SBAR() __builtin_amdgcn_sched_barrier(0)
__device__ __forceinline__ int v_st(int k, int c) { const int kk = (k & ~0xC) | ((k & 4) << 1) | ((k & 8) >> 1); return ((kk >> 3) * 4 + (c >> 5)) * 512 + ((kk & 7) * 32 + (c & 31)) * 2; }
__device__ __forceinline__ int v_rd_base(int lane) { return ((lane & 3) << 3) | (((lane >> 2) & 3) << 6) | (((lane >> 4) & 1) << 5) | (((lane >> 5) & 1) << 8); }
constexpr int v_rd_off(int d0, int ks, int half) { return d0 * 512 + ks * 4096 + half * 2048; }
__device__ __forceinline__ int crow(int r, int hi) { return (r & 3) + 8 * (r >> 2) + 4 * hi; }
__device__ __forceinline__ bf16x8 load8(const bf16_t* p) { return *reinterpret_cast<const bf16x8*>(p); }
__device__ __forceinline__ void mask_tile(f32x16& p0, f32x16& p1, int dq) {
    const float NEG = -__builtin_inff();
#pragma unroll
    for (int r = 0; r < 16; ++r) {
        const int c = (r & 3) + 8 * (r >> 2);
        if (dq - c < 0) p0[r] = NEG;
        if (dq - c - 32 < 0) p1[r] = NEG;
    }
}
__device__ __forceinline__ void mask_all(f32x16& p0, f32x16& p1) {
    const float NEG = -__builtin_inff();
#pragma unroll
    for (int r = 0; r < 16; ++r) { p0[r] = NEG; p1[r] = NEG; }
}
constexpr float THR = 8.f;
__device__ __forceinline__ void partialSM(f32x16& p0, f32x16& p1, float& m_reg, float& mn, float& alpha, const bool rowmask) {
    float pmax = p0[0];
#pragma unroll
    for (int r = 1; r < 16; ++r) pmax = fmaxf(pmax, p0[r]);
#pragma unroll
    for (int r = 0; r < 16; ++r) pmax = fmaxf(pmax, p1[r]);
    { auto rr = __builtin_amdgcn_permlane32_swap(__float_as_uint(pmax), __float_as_uint(pmax), false, false);
      pmax = fmaxf(__uint_as_float(rr[0]), __uint_as_float(rr[1])); }
    constexpr float C2 = 1.4426950408889634f * SCALE;
    pmax = rowmask ? -__builtin_inff() : pmax;
    if (__builtin_expect(__all((pmax - m_reg) * SCALE <= THR), 1)) { mn = m_reg; alpha = 1.f; }
    else { mn = fmaxf(m_reg, pmax); alpha = __builtin_amdgcn_exp2f((m_reg - mn) * C2); m_reg = mn; }
    const float mnL = rowmask ? -__builtin_inff() : -mn * C2;
#pragma unroll
    for (int r = 0; r < 16; ++r) p0[r] = fmaf(p0[r], C2, mnL);
#pragma unroll
    for (int r = 0; r < 16; ++r) p1[r] = fmaf(p1[r], C2, mnL);
#pragma unroll
    for (int r = 0; r < 16; ++r) p0[r] = __builtin_amdgcn_exp2f(p0[r]);
}
__device__ __forceinline__ void finishSM(f32x16& p0, f32x16& p1, float alpha, float& l_reg, bf16x8& pa0, bf16x8& pa1, bf16x8& pa2, bf16x8& pa3) {
#pragma unroll
    for (int r = 0; r < 16; ++r) p1[r] = __builtin_amdgcn_exp2f(p1[r]);
    float ps = 0;
#pragma unroll
    for (int r = 0; r < 16; ++r) ps += p0[r];
#pragma unroll
    for (int r = 0; r < 16; ++r) ps += p1[r];
    { auto rr = __builtin_amdgcn_permlane32_swap(__float_as_uint(ps), __float_as_uint(ps), false, false);
      ps = __uint_as_float(rr[0]) + __uint_as_float(rr[1]); }
    l_reg = l_reg * alpha + ps;
#define PK4(P, B_, OUT) do { unsigned a0 = cvt_pk_bf16(P[B_+0], P[B_+1]), a1 = cvt_pk_bf16(P[B_+2], P[B_+3]);                          \
        unsigned b0 = cvt_pk_bf16(P[B_+4], P[B_+5]), b1 = cvt_pk_bf16(P[B_+6], P[B_+7]);                                             \
        auto r0 = __builtin_amdgcn_permlane32_swap(a0, b0, false, false); auto r1 = __builtin_amdgcn_permlane32_swap(a1, b1, false, false); \
        u32x4 w = {r0[0], r1[0], r0[1], r1[1]}; OUT = *reinterpret_cast<bf16x8*>(&w); } while (0)
    PK4(p0, 0, pa0); PK4(p0, 8, pa1); PK4(p1, 0, pa2); PK4(p1, 8, pa3);
#undef PK4
}
template <int KB>
__device__ __forceinline__ void qkt(f32x16& p0, f32x16& p1, const char* K_lds, int r32, int hi, const bf16x8* qr) {
    p0 = f32x16{}; p1 = f32x16{};
    const char* kb[4];
#pragma unroll
    for (int dd = 0; dd < 4; ++dd) kb[dd] = K_lds + KB * SHM_K + KSWZ(r32, (dd * 16 + hi * 8) * 2);
#pragma unroll
    for (int d0 = 0; d0 < 8; ++d0) { const char* a = kb[d0 & 3] + (d0 >> 2) * 128;
        bf16x8 b0 = *reinterpret_cast<const bf16x8*>(a);
        bf16x8 b1 = *reinterpret_cast<const bf16x8*>(a + 32 * 256);
        p0 = __builtin_amdgcn_mfma_f32_32x32x16_bf16(b0, qr[d0], p0, 0, 0, 0);
        p1 = __builtin_amdgcn_mfma_f32_32x32x16_bf16(b1, qr[d0], p1, 0, 0, 0); }
}
template <int VB>
__device__ __forceinline__ void pv_tile(f32x16* o, int vb0, bf16x8 pa0, bf16x8 pa1, bf16x8 pa2, bf16x8 pa3) {
#define TRRD(dst, off) asm volatile("ds_read_b64_tr_b16 %0, %1 offset:%2" : "=&v"(dst) : "v"(vb0), "i"(off) : "memory")
#define PV_RD(S_, d0) do { constexpr int b_ = VB * SHM_V + v_rd_off(d0, 0, 0); \
        TRRD(S_##l0, b_); TRRD(S_##h0, b_ + 2048); TRRD(S_##l1, b_ + 4096); TRRD(S_##h1, b_ + 6144); TRRD(S_##l2, b_ + 8192); TRRD(S_##h2, b_ + 10240); TRRD(S_##l3, b_ + 12288); TRRD(S_##h3, b_ + 14336); } while (0)
#define PV_MM(S_, d0) do { \
        o[d0] = __builtin_amdgcn_mfma_f32_32x32x16_bf16(pa0, (bf16x8){S_##l0[0], S_##l0[1], S_##l0[2], S_##l0[3], S_##h0[0], S_##h0[1], S_##h0[2], S_##h0[3]}, o[d0], 0, 0, 0);   \
        o[d0] = __builtin_amdgcn_mfma_f32_32x32x16_bf16(pa1, (bf16x8){S_##l1[0], S_##l1[1], S_##l1[2], S_##l1[3], S_##h1[0], S_##h1[1], S_##h1[2], S_##h1[3]}, o[d0], 0, 0, 0);   \
        o[d0] = __builtin_amdgcn_mfma_f32_32x32x16_bf16(pa2, (bf16x8){S_##l2[0], S_##l2[1], S_##l2[2], S_##l2[3], S_##h2[0], S_##h2[1], S_##h2[2], S_##h2[3]}, o[d0], 0, 0, 0);   \
        o[d0] = __builtin_amdgcn_mfma_f32_32x32x16_bf16(pa3, (bf16x8){S_##l3[0], S_##l3[1], S_##l3[2], S_##l3[3], S_##h3[0], S_##h3[1], S_##h3[2], S_##h3[3]}, o[d0], 0, 0, 0); } while (0)
    s16x4 Al0, Al1, Al2, Al3, Ah0, Ah1, Ah2, Ah3, Bl0, Bl1, Bl2, Bl3, Bh0, Bh1, Bh2, Bh3;
    PV_RD(A, 0);
    asm volatile("s_waitcnt lgkmcnt(0)" ::: "memory"); SBAR(); PV_RD(B, 1); SBAR(); PV_MM(A, 0); SBAR();
    asm volatile("s_waitcnt lgkmcnt(0)" ::: "memory"); SBAR(); PV_RD(A, 2); SBAR(); PV_MM(B, 1); SBAR();
    asm volatile("s_waitcnt lgkmcnt(0)" ::: "memory"); SBAR(); PV_RD(B, 3); SBAR(); PV_MM(A, 2); SBAR();
    asm volatile("s_waitcnt lgkmcnt(0)" ::: "memory"); SBAR(); PV_MM(B, 3);
#undef PV_MM
#undef PV_RD
#undef TRRD
}
template <int VB>
__device__ __forceinline__ void pv_partial(f32x16* o, int vb0, bf16x8 pa0, bf16x8 pa1, bf16x8 pa2, bf16x8 pa3, f32x16& p0, f32x16& p1, float& m_reg, float& mn, float& alpha, const bool rowmask) {
#define TRRD(dst, off) asm volatile("ds_read_b64_tr_b16 %0, %1 offset:%2" : "=&v"(dst) : "v"(vb0), "i"(off) : "memory")
#define PV_RD(S_, d0) do { constexpr int b_ = VB * SHM_V + v_rd_off(d0, 0, 0); \
        TRRD(S_##l0, b_); TRRD(S_##h0, b_ + 2048); TRRD(S_##l1, b_ + 4096); TRRD(S_##h1, b_ + 6144); TRRD(S_##l2, b_ + 8192); TRRD(S_##h2, b_ + 10240); TRRD(S_##l3, b_ + 12288); TRRD(S_##h3, b_ + 14336); } while (0)
#define PV_MM(S_, d0) do { \
        o[d0] = __builtin_amdgcn_mfma_f32_32x32x16_bf16(pa0, (bf16x8){S_##l0[0], S_##l0[1], S_##l0[2], S_##l0[3], S_##h0[0], S_##h0[1], S_##h0[2], S_##h0[3]}, o[d0], 0, 0, 0);   \
        o[d0] = __builtin_amdgcn_mfma_f32_32x32x16_bf16(pa1, (bf16x8){S_##l1[0], S_##l1[1], S_##l1[2], S_##l1[3], S_##h1[0], S_##h1[1], S_##h1[2], S_##h1[3]}, o[d0], 0, 0, 0);   \
        o[d0] = __builtin_amdgcn_mfma_f32_32x32x16_bf16(pa2, (bf16x8){S_##l2[0], S_##l2[1], S_##l2[2], S_##l2[3], S_##h2[0], S_##h2[1], S_##h2[2], S_##h2[3]}, o[d0], 0, 0, 0);   \
        o[d0] = __builtin_amdgcn_mfma_f32_32x32x16_bf16(pa3, (bf16x8){S_##l3[0], S_##l3[1], S_##l3[2], S_##l3[3], S_##h3[0], S_##h3[1], S_##h3[2], S_##h3[3]}, o[d0], 0, 0, 0); } while (0)
    s16x4 Al0, Al1, Al2, Al3, Ah0, Ah1, Ah2, Ah3, Bl0, Bl1, Bl2, Bl3, Bh0, Bh1, Bh2, Bh3;
    constexpr float C2 = 1.4426950408889634f * SCALE;
    PV_RD(A, 0);
    asm volatile("s_waitcnt lgkmcnt(0)" ::: "memory"); SBAR(); PV_RD(B, 1); SBAR();
    PV_MM(A, 0);
    float pmax = p0[0];
#pragma unroll
    for (int r = 1; r < 16; ++r) pmax = fmaxf(pmax, p0[r]);
#pragma unroll
    for (int r = 0; r < 16; ++r) pmax = fmaxf(pmax, p1[r]);
    SBAR();
    asm volatile("s_waitcnt lgkmcnt(0)" ::: "memory"); SBAR(); PV_RD(A, 2); SBAR();
    PV_MM(B, 1);
    { auto rr = __builtin_amdgcn_permlane32_swap(__float_as_uint(pmax), __float_as_uint(pmax), false, false);
      pmax = fmaxf(__uint_as_float(rr[0]), __uint_as_float(rr[1])); }
    pmax = rowmask ? -__builtin_inff() : pmax;
    if (__builtin_expect(__all((pmax - m_reg) * SCALE <= THR), 1)) { mn = m_reg; alpha = 1.f; }
    else { mn = fmaxf(m_reg, pmax); alpha = __builtin_amdgcn_exp2f((m_reg - mn) * C2); m_reg = mn; }
    const float mnL = rowmask ? -__builtin_inff() : -mn * C2;
    SBAR();
    asm volatile("s_waitcnt lgkmcnt(0)" ::: "memory"); SBAR(); PV_RD(B, 3); SBAR();
    PV_MM(A, 2);
#pragma unroll
    for (int r = 0; r < 16; ++r) p0[r] = fmaf(p0[r], C2, mnL);
#pragma unroll
    for (int r = 0; r < 16; ++r) p1[r] = fmaf(p1[r], C2, mnL);
    asm volatile("" : "+v"(p0), "+v"(p1));
    SBAR();
    asm volatile("s_waitcnt lgkmcnt(0)" ::: "memory"); SBAR();
    PV_MM(B, 3);
#pragma unroll
    for (int r = 0; r < 16; ++r) p0[r] = __builtin_amdgcn_exp2f(p0[r]);
    asm volatile("" : "+v"(p0));
#undef PV_MM
#undef PV_RD
#undef TRRD
}
struct BlockRef { int bh, qb; };
struct Seam { bf16x8 qr[8]; bf16x8 st_v0, st_v1, st_k0, st_k1; };
__device__ __forceinline__ const char* q_rows(const unsigned char* ws, const BlockRef& r) { return (const char*)(ws + WS_Q) + ((size_t)r.bh * SEQ + (size_t)r.qb * QB) * (D * 2); }
__device__ __forceinline__ const char* k_head(const unsigned char* ws, const BlockRef& r) { return (const char*)(ws + WS_K) + (size_t)r.bh * SEQ * (D * 2); }
__device__ __forceinline__ const char* v_head(const unsigned char* ws, const BlockRef& r) { return (const char*)(ws + WS_V) + (size_t)r.bh * SEQ * (D * 2); }
__device__ __forceinline__ bf16x8 ld16(const char* sbase, unsigned voff) { return *reinterpret_cast<const bf16x8*>(sbase + voff); }
#define VMW() asm volatile("s_waitcnt vmcnt(0)" ::: "memory")
#define VMWN(n) asm volatile("s_waitcnt vmcnt(%0)" :: "i"(n) : "memory")
#define SLOAD_H(Kp, Vp, k0) do { const char* vt_ = (Vp) + (size_t)(k0) * (D * 2); const char* kt_ = (Kp) + (size_t)(k0) * (D * 2); \
                         S.st_v0 = ld16(vt_, lo0); S.st_v1 = ld16(vt_, lo1); S.st_k0 = ld16(kt_, lo0); S.st_k1 = ld16(kt_, lo1); } while (0)
#define SWRITE_HK(bf) do { *(bf16x8*)(K_lds + (bf) * SHM_K + kws) = S.st_k0; *(bf16x8*)(K_lds + (bf) * SHM_K + kws + 32 * 256) = S.st_k1; } while (0)
#define SWRITE_HV(bf) do { *(bf16x8*)(V_lds + (bf) * SHM_V + vst0) = S.st_v0; *(bf16x8*)(V_lds + (bf) * SHM_V + vst1) = S.st_v1; } while (0)
#define SWRITE_H(bf) do { SWRITE_HV(bf); SWRITE_HK(bf); } while (0)
#define QLOAD(r_) do { const char* qb_ = q_rows(ws, (r_)); _Pragma("unroll") for (int d0 = 0; d0 < 8; ++d0) S.qr[d0] = ld16(qb_, qoff + d0 * 32); } while (0)
__device__ __forceinline__ void moba_prime(const unsigned char* ws, const BlockRef& cur, char* lds, Seam& S, const int wid) {
    const int lane = lane_id(), tid = wid * 64 + lane, r32 = lane & 31, hi = lane >> 5;
    const int sr = tid >> 4, sc = (tid & 15) * 8, kws = KSWZ(sr, sc * 2); char* K_lds = lds + 2 * SHM_V;
    const unsigned lo0 = (unsigned)(sr * D + sc) * 2u, lo1 = lo0 + 32u * D * 2u, qoff = (unsigned)((wid * QBLK + r32) * D + hi * 8) * 2u;
    *(u32x4*)(lds + OFF_KM + tid * 16) = (u32x4){0u, 0u, 0u, 0u};
    QLOAD(cur);
    SLOAD_H(k_head(ws, cur), v_head(ws, cur), 0); VMW(); SWRITE_HK(0);
    __syncthreads();
}
__device__ __forceinline__ void moba_block(const unsigned char* ws_, const BlockRef& cur, const BlockRef& nxt, char* lds, Seam& S, const int wid) {
    unsigned long long wsi = (unsigned long long)ws_; asm volatile("" : "+s"(wsi));
    const unsigned char* ws = (const unsigned char*)(const GAS unsigned char*)wsi;
    const int lane = lane_id(), tid = wid * 64 + lane, r32 = lane & 31, hi = lane >> 5;
    const int qb = cur.qb, NT = 4 * (qb + 1);
    const int qlo = wid * QBLK, qm = qlo + r32 - 4 * hi;
    char* V_lds = lds; char* K_lds = lds + 2 * SHM_V;
    float* wsf = (float*)(lds + OFF_WS) + wid * 64; float* li_l = wsf, * al_l = wsf + 32;
    float m_reg = -1e30f, l_reg = 0; f32x16 o[4] = {};
    const int sr = tid >> 4, sc = (tid & 15) * 8, vst0 = v_st(sr, sc), vst1 = v_st(32 + sr, sc), kws = KSWZ(sr, sc * 2);
    const unsigned lo0 = (unsigned)(sr * D + sc) * 2u, lo1 = lo0 + 32u * D * 2u, qoff = (unsigned)((wid * QBLK + r32) * D + hi * 8) * 2u;
    const int vb0 = (int)(uintptr_t)V_lds + v_rd_base(lane);
    const char* Kh = k_head(ws, cur); const char* Vh = v_head(ws, cur);
    unsigned sel = 0u;
    if (qb > 0) {
        if (tid < 256) { const int row = tid >> 4, ch = tid & 15; *(bf16x8*)(lds + OFF_KM + KSWZ(row, ch * 16)) = ld16((const char*)(ws + WS_KMEAN) + (size_t)cur.bh * NBLK * (D * 2), (unsigned)(row * D + ch * 8) * 2u); }
        __syncthreads();
        f32x16 g = f32x16{};
        { const char* kmb[4];
#pragma unroll
          for (int dd = 0; dd < 4; ++dd) kmb[dd] = lds + OFF_KM + KSWZ(r32, (dd * 16 + hi * 8) * 2);
#pragma unroll
          for (int d0 = 0; d0 < 8; ++d0) { const bf16x8 b0 = *reinterpret_cast<const bf16x8*>(kmb[d0 & 3] + (d0 >> 2) * 128); g = __builtin_amdgcn_mfma_f32_32x32x16_bf16(b0, S.qr[d0], g, 0, 0, 0); } }
        float gv[16];
#pragma unroll
        for (int r = 0; r < 8; ++r) { const float mine = g[r], oth = __shfl_xor(mine, 32); const int kb_ = (r & 3) + 8 * (r >> 2);
            gv[kb_] = hi ? oth : mine; gv[kb_ + 4] = hi ? mine : oth; }
        const float NEGI = -__builtin_inff();
#pragma unroll
        for (int n = 0; n < 16; ++n) if (n >= qb) gv[n] = NEGI;
#pragma unroll
        for (int k = 0; k < 3; ++k) { float best = NEGI; int bi = -1;
#pragma unroll
            for (int n = 0; n < 16; ++n) { const bool ok = (((sel >> n) & 1u) == 0u) && (gv[n] > best); best = ok ? gv[n] : best; bi = ok ? n : bi; }
            if (bi >= 0) sel |= 1u << bi; }
    }
#define RESC(a) do { if (__any((a) < 1.f)) { if (hi == 0) al_l[r32] = (a); asm volatile("s_waitcnt lgkmcnt(0)" ::: "memory");              \
                     _Pragma("unroll") for (int d_ = 0; d_ < 4; ++d_) _Pragma("unroll") for (int r = 0; r < 16; ++r) o[d_][r] *= al_l[crow(r, hi)]; } } while (0)
#define KBASE(t) ((t) * KVBLK)
#define MASKT(P0_, P1_, t, RM_) do { const int jb_ = (t) >> 2; RM_ = (jb_ != qb) && (((sel >> jb_) & 1u) == 0u);                                          \
                                if (jb_ == qb) { const int kb_ = ((t) & 3) * KVBLK; if (kb_ + KVBLK - 1 > qlo) mask_tile(P0_, P1_, qm - kb_); } } while (0)
    constexpr int NQL = 8;
#define SEAM_K0() do { VMWN(NQL); SWRITE_HK(0); SBAR(); } while (0)
    f32x16 pA0, pA1, pB0, pB1; float mnA, mnB, alA, alB; bf16x8 pa0, pa1, pa2, pa3;
    SWRITE_HV(0); SBAR();
    if (NT > 1) { SLOAD_H(Kh, Vh, KBASE(1)); }
    SBAR(); qkt<0>(pA0, pA1, K_lds, r32, hi, S.qr);
    { bool rm_; MASKT(pA0, pA1, 0, rm_); partialSM(pA0, pA1, m_reg, mnA, alA, rm_); }
    if (NT > 1) { VMW(); SWRITE_H(1); }
    __syncthreads();
#define HALF_STEP(PX0, PX1, mnX, alX, PY0, PY1, alY, t, KB, VB, SB) do {                                                      \
        SBAR(); if ((t) + 1 < NT) { SLOAD_H(Kh, Vh, KBASE((t) + 1)); SBAR(); }                                               \
        qkt<KB>(PX0, PX1, K_lds, r32, hi, S.qr);                                             \
        finishSM(PY0, PY1, alY, l_reg, pa0, pa1, pa2, pa3); SBAR();                                                           \
        { bool rm_; MASKT(PX0, PX1, (t), rm_); pv_partial<VB>(o, vb0, pa0, pa1, pa2, pa3, PX0, PX1, m_reg, mnX, alX, rm_); }                                                               \
        if ((t) + 1 < NT) { VMW(); SWRITE_HK(SB); }        \
        __syncthreads();                                                                                                      \
        if ((t) + 1 < NT) { SWRITE_HV(SB); }                                                                                \
        __syncthreads(); RESC(alX); } while (0)
    for (int t = 1; t + 1 < NT; t += 2) {
        HALF_STEP(pB0, pB1, mnB, alB, pA0, pA1, alA, t, 1, 0, 0);
        HALF_STEP(pA0, pA1, mnA, alA, pB0, pB1, alB, t + 1, 0, 1, 1);
    }
    const bool even = (NT & 1) == 0;
    if (even) { SBAR(); qkt<1>(pB0, pB1, K_lds, r32, hi, S.qr); SBAR(); }
    SLOAD_H(k_head(ws, nxt), v_head(ws, nxt), 0); SBAR();
    QLOAD(nxt);
    SBAR();
    finishSM(pA0, pA1, alA, l_reg, pa0, pa1, pa2, pa3); SBAR();
    pv_tile<0>(o, vb0, pa0, pa1, pa2, pa3);
    if (even) { { bool rm_; MASKT(pB0, pB1, NT - 1, rm_); partialSM(pB0, pB1, m_reg, mnB, alB, rm_); } __syncthreads(); RESC(alB);
        finishSM(pB0, pB1, alB, l_reg, pa0, pa1, pa2, pa3); SBAR(); pv_tile<1>(o, vb0, pa0, pa1, pa2, pa3); }
    SBAR(); SEAM_K0();
    if (hi == 0) li_l[r32] = l_reg; asm volatile("s_waitcnt lgkmcnt(0)" ::: "memory");
    float rli[16];
#pragma unroll
    for (int r = 0; r < 16; ++r) rli[r] = __builtin_amdgcn_rcpf(li_l[crow(r, hi)]);
    { const int b = cur.bh / NH, h = cur.bh % NH;
      int r32e = r32, hie = hi; asm volatile("" : "+v"(r32e), "+v"(hie));
      const float so = ((const float*)(ws + WS_SCL))[NE + 2];
      char* Ob = (char*)(ws + WS_O) + (((size_t)b * SEQ + (size_t)qb * QB + (size_t)(wid * QBLK)) * LDO + (size_t)h * D);
      const unsigned obase = (unsigned)(4 * hie * LDO + r32e);
#pragma unroll
      for (int r = 0; r < 16; ++r) { const unsigned ooff = obase + (unsigned)(((r & 3) + 8 * (r >> 2)) * LDO); const float sc_ = rli[r] * so;
#pragma unroll
        for (int d0 = 0; d0 < 4; ++d0) { const float v = o[d0][r] * sc_;
            const float v1 = quad_xor1(v), v2 = quad_xor2(v), v3 = quad_xor2(v1);
            int pk = __builtin_amdgcn_cvt_pk_fp8_f32(v, v1, 0, false); pk = __builtin_amdgcn_cvt_pk_fp8_f32(v2, v3, pk, true);
            if ((r32e & 3) == 0) *(unsigned*)(Ob + ooff + d0 * 32) = (unsigned)pk; } } }
    __syncthreads();
#undef RESC
#undef KBASE
#undef MASKT
#undef SEAM_K0
#undef HALF_STEP
}
#undef VMW
#undef VMWN
#undef SLOAD_H
#undef SWRITE_HK
#undef SWRITE_HV
#undef SWRITE_H
#undef QLOAD
__device__ __forceinline__ BlockRef block_ref(int item, int pass) { BlockRef r; r.bh = item >> 3; const int y = item & 7; r.qb = pass ? (NBLK - 1 - y) : y; return r; }
template <class Side> __device__ __forceinline__ void attn_phase(char* lds, const unsigned char* ws, int G, int vcu, const int wid, const Side& side) {
    constexpr int NITEMS = NB * NH * (NBLK / 2);
    const int ipc = (NITEMS + G - 1) / G, first = vcu * ipc; int last = first + ipc; if (last > NITEMS) last = NITEMS;
    if (first >= last) { side(0, 1); return; }
    const int nblk = 2 * (last - first);
    side(0, nblk + 1);
    BlockRef cur = block_ref(first, 0);
    Seam S;
    moba_prime(ws, cur, lds, S, wid);
    for (int k = 0; k < nblk; ++k) {
        const int kn = (k + 1 < nblk) ? k + 1 : k;
        const BlockRef nxt = block_ref(first + (kn >> 1), kn & 1);
        moba_block(ws, cur, nxt, lds, S, wid);
        side(k + 1, nblk + 1);
        cur = nxt;
    }
}
#undef KSWZ
#undef SBAR
}

struct Frame {
    LAS unsigned char* lds;
    volatile LAS unsigned* MISC;
    unsigned* ctl;
    int wave, vcu, G;
    unsigned char* ws;
    __device__ __forceinline__ const float* in(int k) const { const volatile LAS unsigned* p = MISC + 64 + 2 * k; const unsigned lo = __builtin_amdgcn_readfirstlane((int)p[0]), hi = __builtin_amdgcn_readfirstlane((int)p[1]);
        return (const float*)(const GAS float*)(((unsigned long long)hi << 32) | lo); }
    float* out;
};
enum { I_X = 0, I_POOLW, I_POOLS, I_WKV, I_WQ, I_WO, I_FG, I_FU, I_FD, I_MR, I_MG, I_MU, I_MD, I_LMG, I_LMB, I_LFG, I_LFB };

template <int MODE> __device__ __forceinline__ int rowmap(int n) {
    if (MODE == 0) return n;
    if (MODE == 1) return (n >> 7) * 256 + (n & 127);
    if (MODE == 2) return (n >> 7) * 256 + 128 + (n & 127);
    const int h = n >> 7, d = n & 127;
    return (h >> 1) * 256 + (d >> 6) * 128 + (h & 1) * 64 + (d & 63);
}
template <int MODE> __device__ __forceinline__ void transpose_item(const float* W, int K, int N, int ldw, bf16_t* WT, LAS float* scr, int item, int lane) {
    const int nblk = N / 32, kb = item / nblk, nb = item % nblk, k0 = 64 * kb, n0 = 32 * nb;
#pragma unroll 8
    for (int i = 0; i < 32; ++i) { const int kk = 2 * i + (lane >> 5); scr[kk * 33 + (lane & 31)] = W[(size_t)(k0 + kk) * ldw + n0 + (lane & 31)]; }
    LDS_WAIT(); asm volatile("" ::: "memory");
    const int c = lane & 7;
#pragma unroll
    for (int j = 0; j < 4; ++j) { const int n = (lane >> 3) + 8 * j; const LAS float* s = scr + (8 * c) * 33 + n;
        u32x4 o; o.x = cvt_pk_bf16(s[0 * 33], s[1 * 33]); o.y = cvt_pk_bf16(s[2 * 33], s[3 * 33]); o.z = cvt_pk_bf16(s[4 * 33], s[5 * 33]); o.w = cvt_pk_bf16(s[6 * 33], s[7 * 33]);
        *(u32x4*)(WT + (size_t)rowmap<MODE>(n0 + n) * K + k0 + 8 * c) = o; }
    LDS_WAIT(); asm volatile("" ::: "memory");
}
__device__ __forceinline__ void convert_family(Frame& F, const float* W, int K, int N, size_t src_stride, bf16_t* WT, size_t dst_stride, int nmat) {
    const int lane_ = lane_id(), tid_ = F.wave * 64 + lane_; (void)tid_;
    constexpr int PITCH = 528;
    LAS unsigned char* tile = F.lds + RING_OFF;
    const int KT = K / 256, NT_ = N / 64, per = KT * NT_, total = per * nmat;
    const int cg = lane_ & 15, slot = F.wave * 4 + (lane_ >> 4);
    for (int it = F.vcu; it < total; it += F.G) { const int mi = it / per, r = it - mi * per, kt = r / NT_, nt = r - kt * NT_;
        const float* src = W + (size_t)mi * src_stride + ((size_t)kt * 256 + slot * 8) * N + nt * 64 + 4 * cg;
        f32x4 v[8];
#pragma unroll
        for (int i = 0; i < 8; ++i) v[i] = *(const f32x4*)(src + (size_t)i * N);
#pragma unroll
        for (int c = 0; c < 4; ++c) { u32x4 o; o.x = cvt_pk_bf16(v[0][c], v[1][c]); o.y = cvt_pk_bf16(v[2][c], v[3][c]); o.z = cvt_pk_bf16(v[4][c], v[5][c]); o.w = cvt_pk_bf16(v[6][c], v[7][c]);
            *(LAS u32x4*)(tile + (4 * cg + c) * PITCH + slot * 16) = o; }
        __syncthreads();
        bf16_t* dst = WT + (size_t)mi * dst_stride;
#pragma unroll
        for (int p = 0; p < 4; ++p) { const int n = p * 16 + (tid_ >> 5), kb = (tid_ & 31) * 16;
            *(u32x4*)((unsigned char*)(dst + (size_t)(nt * 64 + n) * K + kt * 256) + kb) = *(const LAS u32x4*)(tile + n * PITCH + kb); }
        __syncthreads(); }
}
__device__ __forceinline__ int rowmap_rt(int mode, int n) { return mode == 0 ? rowmap<0>(n) : mode == 1 ? rowmap<1>(n) : mode == 2 ? rowmap<2>(n) : rowmap<3>(n); }
struct StripDesc { const float* W; int ldw, n0, mode; i8_t* WT; float* SW; };
constexpr int NS_M = NE * 2 * (DFE / 32), NS_F = 2 * (DFF / 32), NS_Q = 3 * (DM / 32);
__device__ __forceinline__ void strip_load(f32x4 (&v)[32], const StripDesc& d, int cg, int slot) {
    const float* src = d.W + (size_t)(slot * 32) * d.ldw + d.n0 + 4 * cg;
#pragma unroll
    for (int i = 0; i < 32; ++i) v[i] = __builtin_nontemporal_load((const f32x4*)(src + (size_t)i * d.ldw));
}
template <class Item> __device__ __forceinline__ void quant_strips(Frame& F, LAS unsigned char* tile, int j0, int j1, const Item& item) {
    const int lane_ = lane_id(), tid_ = F.wave * 64 + lane_;
    LAS float* red = (LAS float*)(tile + 32 * 2064);
    const int cg = lane_ & 7, slot = F.wave * 8 + (lane_ >> 3);
    f32x4 v[32]; StripDesc cur, nx;
    bool have = (j0 < j1) && item(j0, cur);
    if (have) strip_load(v, cur, cg, slot);
    for (int j = j0; have; ++j) {
        f32x4 mx = (f32x4){0.f, 0.f, 0.f, 0.f};
#pragma unroll
        for (int i = 0; i < 32; ++i) mx = __builtin_elementwise_max(mx, __builtin_elementwise_abs(v[i]));
#pragma unroll
        for (int c = 0; c < 4; ++c) { float t = mx[c]; t = fmaxf(t, __shfl_xor(t, 8)); t = fmaxf(t, __shfl_xor(t, 16)); t = fmaxf(t, __shfl_xor(t, 32)); mx[c] = t; }
        if ((lane_ >> 3) == 0) *(LAS f32x4*)(red + F.wave * 32 + 4 * cg) = mx;
        __syncthreads();
        f32x4 cm = *(const LAS f32x4*)(red + 4 * cg);
#pragma unroll
        for (int w = 1; w < 8; ++w) cm = __builtin_elementwise_max(cm, *(const LAS f32x4*)(red + w * 32 + 4 * cg));
        f32x4 inv, sc;
#pragma unroll
        for (int c = 0; c < 4; ++c) { sc[c] = cm[c] > 0.f ? cm[c] * (1.f / 127.f) : 1.f; inv[c] = cm[c] > 0.f ? 127.f / cm[c] : 0.f; }
        const bool hn = (j + 1 < j1) && item(j + 1, nx);
        const float* nsrc = hn ? nx.W + (size_t)(slot * 32) * nx.ldw + nx.n0 + 4 * cg : nullptr; const size_t nld = hn ? (size_t)nx.ldw : 0;
#pragma unroll
        for (int p8 = 0; p8 < 4; ++p8) {
#pragma unroll
            for (int c = 0; c < 4; ++c) { u32x2 d;
                d.x = pack_i8x4(v[8 * p8][c] * inv[c], v[8 * p8 + 1][c] * inv[c], v[8 * p8 + 2][c] * inv[c], v[8 * p8 + 3][c] * inv[c]);
                d.y = pack_i8x4(v[8 * p8 + 4][c] * inv[c], v[8 * p8 + 5][c] * inv[c], v[8 * p8 + 6][c] * inv[c], v[8 * p8 + 7][c] * inv[c]);
                *(LAS u32x2*)(tile + (4 * cg + c) * 2064 + slot * 32 + 8 * p8) = d; }
            asm volatile("" ::: "memory");
            if (hn) {
#pragma unroll
                for (int i = 8 * p8; i < 8 * p8 + 8; ++i) v[i] = __builtin_nontemporal_load((const f32x4*)(nsrc + (size_t)i * nld)); }
            asm volatile("" ::: "memory");
        }
        if (slot == 0) {
#pragma unroll
            for (int c = 0; c < 4; ++c) cur.SW[rowmap_rt(cur.mode, cur.n0 + 4 * cg + c)] = sc[c]; }
        __syncthreads();
#pragma unroll
        for (int it = 0; it < 8; ++it) { const int n = it * 4 + (tid_ >> 7), kb = (tid_ & 127) * 16;
            __builtin_nontemporal_store(*(const LAS u32x4*)(tile + n * 2064 + kb), (u32x4*)(cur.WT + (size_t)rowmap_rt(cur.mode, cur.n0 + n) * 2048 + kb)); }
        __syncthreads();
        cur = nx; have = hn;
    }
}
struct MoeStripItem { Frame& F;
    __device__ __forceinline__ bool operator()(int j, StripDesc& d) const { const int st = F.vcu + F.G * j; if (st >= NS_M) return false;
        const int e = st / (2 * (DFE / 32)), r = st % (2 * (DFE / 32)), up = r >= DFE / 32 ? 1 : 0;
        d.W = (up ? F.in(I_MU) : F.in(I_MG)) + (size_t)e * DM * DFE; d.ldw = DFE; d.n0 = 32 * (r - up * (DFE / 32)); d.mode = 1 + up;
        d.WT = (i8_t*)(F.ws + WS_MWGU) + (size_t)e * 2 * DFE * DM; d.SW = (float*)(F.ws + WS_SWM) + (size_t)e * 2 * DFE; return true; } };
struct DenseStripItem { Frame& F;
    __device__ __forceinline__ bool operator()(int j, StripDesc& d) const { const int st = F.vcu + F.G * j; if (st >= NS_F + NS_Q) return false;
        if (st < NS_F) { const int up = st >= DFF / 32 ? 1 : 0; d.W = up ? F.in(I_FU) : F.in(I_FG); d.ldw = DFF; d.n0 = 32 * (st - up * (DFF / 32)); d.mode = 1 + up;
            d.WT = (i8_t*)(F.ws + WS_WGU); d.SW = (float*)(F.ws + WS_SWGU); }
        else { const int r = st - NS_F, which = r / (DM / 32); d.W = which == 0 ? F.in(I_WQ) : (which == 1 ? F.in(I_WKV) : F.in(I_WKV) + DM); d.ldw = which == 0 ? DM : 2 * DM;
            d.n0 = 32 * (r % (DM / 32)); d.mode = which == 2 ? 0 : 3; d.WT = (i8_t*)(F.ws + WS_WQKV) + (size_t)which * DM * DM; d.SW = (float*)(F.ws + WS_SWQKV) + which * DM; }
        return true; } };
__device__ __forceinline__ void quant_weights(Frame& F) { quant_strips(F, F.lds + RING_OFF, 0, (NS_F + NS_Q + F.G - 1) / F.G, DenseStripItem{F}); }
__device__ __forceinline__ void down_scale_sample(Frame& F) {
    const int lane_ = lane_id(), tid_ = F.wave * 64 + lane_;
    LAS float* red = (LAS float*)(F.lds + RING_OFF);
    if (F.vcu < NE + 2) { const int w = F.vcu; const int K = w < NE ? DFE : (w == NE ? DFF : DM); const float* W = w < NE ? F.in(I_MD) + (size_t)w * DFE * DM : (w == NE ? F.in(I_FD) : F.in(I_WO));
        f32x4 mx = (f32x4){0.f, 0.f, 0.f, 0.f};
#pragma unroll 8
        for (int i = 0; i < 32; ++i) mx = __builtin_elementwise_max(mx, __builtin_elementwise_abs(*(const f32x4*)(W + (size_t)i * (K / 32) * DM + 4 * tid_)));
        const float m = wave_max(fmaxf(fmaxf(mx[0], mx[1]), fmaxf(mx[2], mx[3])));
        if (lane_ == 0) red[F.wave] = m;
        __syncthreads();
        if (tid_ == 0) { float t = red[0]; for (int i = 1; i < NWAVES; ++i) t = fmaxf(t, red[i]);
            const unsigned eb = (__float_as_uint(t) >> 23) & 0xffu;
            ((float*)(F.ws + WS_SCL))[w] = (eb < 5u || eb > 250u) ? 1.0f : __uint_as_float((258u - eb) << 23); }
        __syncthreads();
    }
}
__device__ __forceinline__ void down_quant(Frame& F, LAS unsigned char* tile, const float* W, int K, int nmat, const float* scl, unsigned char* WT, int j0, int j1) {
    const int lane_ = lane_id(), tid_ = F.wave * 64 + lane_;
    constexpr int NT_ = DM / 64, TK = 512, RPT = TK / 32, PITCH = TK + 16;
    const int KT = K / TK, PER = KT * NT_, TOTAL = PER * nmat;
    const int cg = lane_ & 15, slot = F.wave * 4 + (lane_ >> 4);
    f32x4 v[RPT], nv[RPT];
    bool have = j0 < j1 && F.vcu + F.G * j0 < TOTAL;
    if (have) { const int it = F.vcu + F.G * j0, e = it / PER, r = it % PER, kt = r / NT_, nt = r % NT_; const float* src = W + ((size_t)e * K + (size_t)kt * TK + slot * RPT) * DM + nt * 64 + 4 * cg;
#pragma unroll
        for (int i = 0; i < RPT; ++i) nv[i] = __builtin_nontemporal_load((const f32x4*)(src + (size_t)i * DM)); }
    for (int j = j0; have; ++j) { const int it = F.vcu + F.G * j;
        const int e = it / PER, r = it % PER, kt = r / NT_, nt = r % NT_;
#pragma unroll
        for (int i = 0; i < RPT; ++i) v[i] = nv[i];
        const int itn = it + F.G; const bool hn = (j + 1 < j1) && itn < TOTAL;
        if (hn) { const int e2 = itn / PER, r2 = itn % PER, kt2 = r2 / NT_, nt2 = r2 % NT_; const float* src = W + ((size_t)e2 * K + (size_t)kt2 * TK + slot * RPT) * DM + nt2 * 64 + 4 * cg;
#pragma unroll
            for (int i = 0; i < RPT; ++i) nv[i] = __builtin_nontemporal_load((const f32x4*)(src + (size_t)i * DM)); }
        const float sc_ = __uint_as_float((unsigned)__builtin_amdgcn_readfirstlane((int)__float_as_uint(scl[e])));
#define Q8(x) fminf(fmaxf((x) * sc_, -448.f), 448.f)
#pragma unroll
        for (int c = 0; c < 4; ++c) { u32x4 d;
#pragma unroll
            for (int q = 0; q < 4; ++q) { int p0 = __builtin_amdgcn_cvt_pk_fp8_f32(Q8(v[4 * q][c]), Q8(v[4 * q + 1][c]), 0, false); p0 = __builtin_amdgcn_cvt_pk_fp8_f32(Q8(v[4 * q + 2][c]), Q8(v[4 * q + 3][c]), p0, true); d[q] = (unsigned)p0; }
            *(LAS u32x4*)(tile + (4 * cg + c) * PITCH + slot * RPT) = d; }
#undef Q8
        __syncthreads();
#pragma unroll
        for (int p = 0; p < 4; ++p) { const int n = p * 16 + (tid_ >> 5), kb = (tid_ & 31) * 16;
            __builtin_nontemporal_store(*(const LAS u32x4*)(tile + n * PITCH + kb), (u32x4*)(WT + ((size_t)e * DM + nt * 64 + n) * K + kt * TK + kb)); }
        __syncthreads();
        have = hn;
    }
}
__device__ __forceinline__ void moe_side_work(Frame& F, int slot, int nslots) {
    { const int g3 = (F.vcu >> 3) % 3, mine = g3 == 0 ? 0 : (g3 == 1 ? nslots / 2 : nslots - 1);
      if (slot != mine) return; }
    LAS unsigned char* tile = F.lds + SIDE_OFF;
    quant_strips(F, tile, 0, (NS_M + F.G - 1) / F.G, MoeStripItem{F});
    down_quant(F, tile, F.in(I_MD), DFE, NE, (const float*)(F.ws + WS_SCL), F.ws + WS_MWD, 0, (NE * (DFE / 512) * (DM / 64) + F.G - 1) / F.G);
}
__device__ __forceinline__ void rope_tables(Frame& F) {
    const int lane_ = lane_id(), tid_ = F.wave * 64 + lane_; (void)tid_;
    float* cs = (float*)(F.ws + WS_COS); float* sn = (float*)(F.ws + WS_SIN);
    const int gt = F.vcu * NTHREADS + tid_, NGT = F.G * NTHREADS;
    for (int e = gt; e < SEQ * 64; e += NGT) { const int pos = e >> 6, i = e & 63;
        const float inv = 1.0f / __builtin_exp2f((float)i * (13.287712379549449f / 64.0f));
        const float angf = (float)pos * inv;
        const double turns = (double)angf * 0.15915494309189535; const double fr = turns - __builtin_floor(turns);
        const float frf = (float)fr;
        cs[e] = __builtin_amdgcn_cosf(frf); sn[e] = __builtin_amdgcn_sinf(frf); }
}
__device__ __forceinline__ void pool_diff(Frame& F) {
    const int lane_ = lane_id(), tid_ = F.wave * 64 + lane_; (void)tid_;
    bf16_t* diff = (bf16_t*)(F.ws + WS_DIFF); const float* x = F.in(I_X);
    const int gw = F.vcu * NWAVES + F.wave, NGW = F.G * NWAVES;
    for (int it = gw; it < (M / 32) * 8; it += NGW) { const int j = it & 7, r0 = (it >> 3) * 32, s0 = r0 & (SEQ - 1), w = 2 << (j >> 1);
        const float* xp = x + (size_t)r0 * DM + 256 * j + 4 * lane_; bf16_t* dp = diff + (size_t)r0 * DM + 256 * j + 4 * lane_;
        f32x4 sum = (f32x4){0.f, 0.f, 0.f, 0.f};
        const int have = (s0 + 1 < w) ? s0 + 1 : w;
        for (int i = 1; i < have; ++i) sum += *(const f32x4*)(xp - (size_t)i * DM);
#pragma unroll 16
        for (int rr = 0; rr < 32; ++rr) { const int s = s0 + rr; const f32x4 x0 = *(const f32x4*)(xp + (size_t)rr * DM); sum += x0;
            const int cnt = (s + 1 < w) ? s + 1 : w; const float ic = 1.0f / (float)cnt; const f32x4 d = sum * ic - x0;
            u32x2 o; o.x = cvt_pk_bf16(d[0], d[1]); o.y = cvt_pk_bf16(d[2], d[3]); *(u32x2*)(dp + (size_t)rr * DM) = o;
            if (s + 1 >= w) sum -= *(const f32x4*)(xp + (size_t)(rr - (w - 1)) * DM); } }
}
__device__ __forceinline__ void ln_inplace(f32x4 (&v)[8], const float* g, const float* b, int lane) {
    float s = 0.f;
#pragma unroll
    for (int j = 0; j < 8; ++j) s += (v[j][0] + v[j][1]) + (v[j][2] + v[j][3]);
    const float mean = wave_sum(s) * (1.f / DM); float s2 = 0.f;
#pragma unroll
    for (int j = 0; j < 8; ++j) { v[j] = v[j] - mean; s2 += (v[j][0] * v[j][0] + v[j][1] * v[j][1]) + (v[j][2] * v[j][2] + v[j][3] * v[j][3]); }
    const float rstd = 1.f / sqrtf(wave_sum(s2) * (1.f / DM) + LN_EPS);
#pragma unroll
    for (int j = 0; j < 8; ++j) { const f32x4 gg = *(const f32x4*)(g + 256 * j + 4 * lane), bb = *(const f32x4*)(b + 256 * j + 4 * lane); v[j] = v[j] * rstd * gg + bb; }
}
__device__ __forceinline__ f32x4 bf16x4_to_f32(const u32x2 w) { f32x4 r; r[0] = __uint_as_float(w.x << 16); r[1] = __uint_as_float(w.x & 0xffff0000u); r[2] = __uint_as_float(w.y << 16); r[3] = __uint_as_float(w.y & 0xffff0000u); return r; }
__device__ __forceinline__ f32x4 ld_bf16x4(const bf16_t* p) { const u32x2 w = *(const u32x2*)p; f32x4 r; r[0] = __uint_as_float(w.x << 16); r[1] = __uint_as_float(w.x & 0xffff0000u); r[2] = __uint_as_float(w.y << 16); r[3] = __uint_as_float(w.y & 0xffff0000u); return r; }
__device__ __forceinline__ void store_row_f32_q(const f32x4 (&v)[8], bf16_t* xf, i8_t* xq, float* sxp, int lane) {
    float am = 0.f;
#pragma unroll
    for (int j = 0; j < 8; ++j) am = fmaxf(fmaxf(am, fmaxf(fabsf(v[j][0]), fabsf(v[j][1]))), fmaxf(fabsf(v[j][2]), fabsf(v[j][3])));
    am = wave_max(am);
    const float sc = am > 0.f ? am * (1.f / 127.f) : 1.f, inv = am > 0.f ? 127.f / am : 0.f;
#pragma unroll
    for (int j = 0; j < 8; ++j) { u32x2 o; o.x = cvt_pk_bf16(v[j][0], v[j][1]); o.y = cvt_pk_bf16(v[j][2], v[j][3]); *(u32x2*)(xf + 256 * j + 4 * lane) = o; *(unsigned*)(xq + 256 * j + 4 * lane) = pack_i8x4(v[j][0] * inv, v[j][1] * inv, v[j][2] * inv, v[j][3] * inv); }
    if (lane == 0) *sxp = sc;
}
__device__ __forceinline__ void ln_phase(Frame& F, const bf16_t* u, const float* g, const float* b) {
    const int lane_ = lane_id(), tid_ = F.wave * 64 + lane_; (void)tid_;
    bf16_t* XF = (bf16_t*)(F.ws + WS_XF); i8_t* XQ = (i8_t*)(F.ws + WS_XB); float* SX = (float*)(F.ws + WS_SX);
    const int gw = F.vcu * NWAVES + F.wave, NGW = F.G * NWAVES;
    u32x2 nw[8];
    if (gw < M) {
#pragma unroll
        for (int j = 0; j < 8; ++j) nw[j] = *(const u32x2*)(u + (size_t)gw * DM + 256 * j + 4 * lane_); }
    for (int m = gw; m < M; m += NGW) { f32x4 v[8];
#pragma unroll
        for (int j = 0; j < 8; ++j) v[j] = bf16x4_to_f32(nw[j]);
        { const int mn = (m + NGW < M) ? m + NGW : m;
#pragma unroll
          for (int j = 0; j < 8; ++j) nw[j] = *(const u32x2*)(u + (size_t)mn * DM + 256 * j + 4 * lane_); }
        ln_inplace(v, g, b, lane_);
        store_row_f32_q(v, XF + (size_t)m * DM, XQ + (size_t)m * DM, SX + m, lane_); }
}
__device__ __forceinline__ void ln_router_phase(Frame& F, const bf16_t* u, const float* g, const float* b) {
    const int lane_ = lane_id(), tid_ = F.wave * 64 + lane_; (void)tid_;
    bf16_t* XF = (bf16_t*)(F.ws + WS_XF); i8_t* XQ = (i8_t*)(F.ws + WS_XB); float* SX = (float*)(F.ws + WS_SX);
    int* tokE = (int*)(F.ws + WS_TOKE); float* tokG = (float*)(F.ws + WS_TOKG); int* tokR = (int*)(F.ws + WS_TOKR);
    LAS float* wr = (LAS float*)(F.lds + RING_OFF);
    LAS int* lcnt = (LAS int*)(F.lds + RING_OFF + 65536);
    for (int i = tid_; i < DM * NE / 4; i += NTHREADS) ((LAS f32x4*)wr)[i] = ((const f32x4*)F.in(I_MR))[i];
    if (tid_ < 16) lcnt[tid_] = 0;
    __syncthreads();
    const int rows_per_wg = (M + F.G - 1) / F.G, m0 = F.vcu * rows_per_wg; int m1 = m0 + rows_per_wg; if (m1 > M) m1 = M;
    u32x2 nw[8];
    if (m0 + F.wave < m1) {
#pragma unroll
        for (int j = 0; j < 8; ++j) nw[j] = *(const u32x2*)(u + (size_t)(m0 + F.wave) * DM + 256 * j + 4 * lane_); }
    for (int m = m0 + F.wave; m < m1; m += NWAVES) { f32x4 v[8];
#pragma unroll
        for (int j = 0; j < 8; ++j) v[j] = bf16x4_to_f32(nw[j]);
        { const int mn = (m + NWAVES < m1) ? m + NWAVES : m;
#pragma unroll
          for (int j = 0; j < 8; ++j) nw[j] = *(const u32x2*)(u + (size_t)mn * DM + 256 * j + 4 * lane_); }
        ln_inplace(v, g, b, lane_);
        store_row_f32_q(v, XF + (size_t)m * DM, XQ + (size_t)m * DM, SX + m, lane_);
        float lg[8];
#pragma unroll
        for (int e = 0; e < 8; ++e) lg[e] = 0.f;
#pragma unroll
        for (int j = 0; j < 8; ++j)
#pragma unroll
            for (int i = 0; i < 4; ++i) { const int k = 256 * j + 4 * lane_ + i; const f32x4 w0 = *(const LAS f32x4*)(wr + k * 8), w1 = *(const LAS f32x4*)(wr + k * 8 + 4); const float xv = v[j][i];
                lg[0] += xv * w0[0]; lg[1] += xv * w0[1]; lg[2] += xv * w0[2]; lg[3] += xv * w0[3]; lg[4] += xv * w1[0]; lg[5] += xv * w1[1]; lg[6] += xv * w1[2]; lg[7] += xv * w1[3]; }
#pragma unroll
        for (int e = 0; e < 8; ++e) lg[e] = wave_sum(lg[e]);
        float b0 = lg[0]; int e0 = 0;
#pragma unroll
        for (int e = 1; e < 8; ++e) if (lg[e] > b0) { b0 = lg[e]; e0 = e; }
        float b1 = -__builtin_inff(); int e1 = 0;
#pragma unroll
        for (int e = 0; e < 8; ++e) if (e != e0 && lg[e] > b1) { b1 = lg[e]; e1 = e; }
        if (lane_ == 0) { const float g1 = 1.0f / (1.0f + __expf(b0 - b1)), g0 = 1.0f - g1;
            const int r0 = atomicAdd((int*)&lcnt[e0], 1), r1 = atomicAdd((int*)&lcnt[e1], 1);
            tokE[2 * m] = e0; tokE[2 * m + 1] = e1; tokG[2 * m] = g0; tokG[2 * m + 1] = g1;
            LAS int* lr = lcnt + 16 + 4 * (m - m0); lr[0] = e0; lr[1] = e1; lr[2] = r0; lr[3] = r1; }
    }
    __syncthreads();
    if (tid_ < 8) lcnt[8 + tid_] = (int)__hip_atomic_fetch_add(F.ctl + CW_CNT + tid_, (unsigned)lcnt[tid_], RLX_AGENT);
    __syncthreads();
    for (int t = tid_; t < 2 * (m1 - m0); t += NTHREADS) { const LAS int* lr = lcnt + 16 + 4 * (t >> 1); const int e = lr[t & 1]; tokR[2 * m0 + t] = lr[2 + (t & 1)] + lcnt[8 + e]; }
}
__device__ __forceinline__ void moe_layout(Frame& F) {
    const int lane_ = lane_id(), tid_ = F.wave * 64 + lane_; (void)tid_;
    if (tid_ == 0) { unsigned rs = 0, ts = 0;
        for (int e = 0; e < NE; ++e) { const unsigned c = __hip_atomic_load(F.ctl + CW_CNT + e, RLX_AGENT), nt = (c + 255u) >> 8; F.MISC[16 + e] = rs; F.MISC[32 + e] = ts; rs += nt * 256u; ts += nt; }
        F.MISC[16 + NE] = rs; F.MISC[32 + NE] = ts; }
    __syncthreads();
}
__device__ __forceinline__ void gather_phase(Frame& F) {
    const int lane_ = lane_id(), tid_ = F.wave * 64 + lane_; (void)tid_;
    const i8_t* XQ = (const i8_t*)(F.ws + WS_XB); i8_t* XS = (i8_t*)(F.ws + WS_XS); const float* SX = (const float*)(F.ws + WS_SX); float* SXS = (float*)(F.ws + WS_SXS);
    const int* tokE = (const int*)(F.ws + WS_TOKE); const int* tokR = (const int*)(F.ws + WS_TOKR); int* tokP = (int*)(F.ws + WS_TOKP);
    const int gw = F.vcu * NWAVES + F.wave, NGW = F.G * NWAVES;
    int ne0 = 0, ne1 = 0, nr0 = 0, nr1 = 0; float nsc = 0.f; u32x4 nv0 = (u32x4){0u, 0u, 0u, 0u}, nv1 = nv0;
    if (gw < M) { ne0 = tokE[2 * gw]; ne1 = tokE[2 * gw + 1]; nr0 = tokR[2 * gw]; nr1 = tokR[2 * gw + 1]; nsc = SX[gw];
        const u32x4* src = (const u32x4*)(XQ + (size_t)gw * DM); nv0 = src[lane_]; nv1 = src[64 + lane_]; }
    for (int m = gw; m < M; m += NGW) {
        const int e0 = ne0, e1 = ne1, r0 = nr0, r1 = nr1; const float sc = nsc; const u32x4 v0 = nv0, v1 = nv1;
        { const int mn = (m + NGW < M) ? m + NGW : m; ne0 = tokE[2 * mn]; ne1 = tokE[2 * mn + 1]; nr0 = tokR[2 * mn]; nr1 = tokR[2 * mn + 1]; nsc = SX[mn];
          const u32x4* src = (const u32x4*)(XQ + (size_t)mn * DM); nv0 = src[lane_]; nv1 = src[64 + lane_]; }
        const int p0 = (int)F.MISC[16 + e0] + r0, p1 = (int)F.MISC[16 + e1] + r1;
        if (lane_ == 0) { tokP[2 * m] = p0; tokP[2 * m + 1] = p1; SXS[p0] = sc; SXS[p1] = sc; }
        u32x4* d0 = (u32x4*)(XS + (size_t)p0 * DM); u32x4* d1 = (u32x4*)(XS + (size_t)p1 * DM);
        d0[lane_] = v0; d1[lane_] = v0; d0[64 + lane_] = v1; d1[64 + lane_] = v1; }
}
__device__ __forceinline__ void final_phase(Frame& F, const float* g, const float* b, const int mode, const int limit) {
    const int lane_ = lane_id();
    const bf16_t* XF = (const bf16_t*)(F.ws + WS_XF); const bf16_t* OE = (const bf16_t*)(F.ws + WS_OE);
    const float* tokG = (const float*)(F.ws + WS_TOKG); const int* tokP = (const int*)(F.ws + WS_TOKP);
    unsigned* done = F.ctl + CW_DONE;
    const int gw = F.vcu * NWAVES + F.wave, NGW = F.G * NWAVES, s = NGW / 8 + 8;
    for (int k = 0; k * NGW < M; ++k) {
        const int m = (mode == 0 ? gw : (gw + s * k) % NGW) + NGW * k; if (m >= M) continue;
        const int p0 = __builtin_amdgcn_readfirstlane(tokP[2 * m]), p1 = __builtin_amdgcn_readfirstlane(tokP[2 * m + 1]);
        if (mode == 0) { if (p0 >= limit || p1 >= limit) continue; }
        else { if (__builtin_amdgcn_readfirstlane((int)done[m]) != 0) continue; }
        f32x4 v[8];
        const float g0 = tokG[2 * m], g1 = tokG[2 * m + 1];
#pragma unroll
        for (int j = 0; j < 8; ++j) { const int col = 256 * j + 4 * lane_; const f32x4 xv = ld_bf16x4(XF + (size_t)m * DM + col);
            const u32x2 a = *(const u32x2*)(OE + (size_t)p0 * DM + col), c = *(const u32x2*)(OE + (size_t)p1 * DM + col);
            f32x4 fa, fc; fa[0] = __uint_as_float(a.x << 16); fa[1] = __uint_as_float(a.x & 0xffff0000u); fa[2] = __uint_as_float(a.y << 16); fa[3] = __uint_as_float(a.y & 0xffff0000u);
            fc[0] = __uint_as_float(c.x << 16); fc[1] = __uint_as_float(c.x & 0xffff0000u); fc[2] = __uint_as_float(c.y << 16); fc[3] = __uint_as_float(c.y & 0xffff0000u);
            v[j] = xv * ALPHA + fa * g0 + fc * g1; }
        ln_inplace(v, g, b, lane_);
#pragma unroll
        for (int j = 0; j < 8; ++j) *(f32x4*)(F.out + (size_t)m * DM + 256 * j + 4 * lane_) = v[j];
        if (mode == 0 && lane_ == 0) done[m] = 1u;
    }
}
__device__ __forceinline__ void kmean_phase(Frame& F) {
    const int lane_ = lane_id(), tid_ = F.wave * 64 + lane_; (void)tid_;
    const bf16_t* Kh = (const bf16_t*)(F.ws + WS_K); bf16_t* KM = (bf16_t*)(F.ws + WS_KMEAN);
    const int gw = F.vcu * NWAVES + F.wave, NGW = F.G * NWAVES;
    for (int it = gw; it < NB * NH * NBLK; it += NGW) { const u32x4* p = (const u32x4*)(Kh + (size_t)it * 256 * HD) + lane_; float s[8];
#pragma unroll
        for (int k = 0; k < 8; ++k) s[k] = 0.f;
#pragma unroll 16
        for (int r = 0; r < 64; ++r) { const u32x4 w = p[r * 64];
            s[0] += __uint_as_float(w.x << 16); s[1] += __uint_as_float(w.x & 0xffff0000u); s[2] += __uint_as_float(w.y << 16); s[3] += __uint_as_float(w.y & 0xffff0000u);
            s[4] += __uint_as_float(w.z << 16); s[5] += __uint_as_float(w.z & 0xffff0000u); s[6] += __uint_as_float(w.w << 16); s[7] += __uint_as_float(w.w & 0xffff0000u); }
#pragma unroll
        for (int k = 0; k < 8; ++k) { s[k] += __shfl_xor(s[k], 16); s[k] += __shfl_xor(s[k], 32); }
        if (lane_ < 16) { u32x4 o; o.x = cvt_pk_bf16(s[0] * (1.f / 256.f), s[1] * (1.f / 256.f)); o.y = cvt_pk_bf16(s[2] * (1.f / 256.f), s[3] * (1.f / 256.f));
            o.z = cvt_pk_bf16(s[4] * (1.f / 256.f), s[5] * (1.f / 256.f)); o.w = cvt_pk_bf16(s[6] * (1.f / 256.f), s[7] * (1.f / 256.f)); ((u32x4*)(KM + (size_t)it * HD))[lane_] = o; } }
    if (F.vcu == 0 && tid_ == 0) { float* scl = (float*)(F.ws + WS_SCL); const unsigned eb = (__hip_atomic_load(F.ctl + CW_VMAX, RLX_AGENT) >> 23) & 0xffu;
        const float so = (eb < 16u || eb > 240u) ? 1.0f : __uint_as_float((261u - eb) << 23);
        scl[NE + 2] = so; scl[NE + 3] = so * scl[NE + 1]; }
}

struct SchedDense {
    pg8::TileOrder T; const char* A; const char* B; size_t astep, bstep;
    __device__ __forceinline__ bool next(int i, pg8::Unit& u) const { int pm, pn; if (!T.pmpn(i, pm, pn)) return false; u.pm = pm; u.pn = pn; u.aux = 0; u.A = A + (size_t)pm * astep; u.B = B + (size_t)pn * bstep; return true; }
};
struct SchedPool {
    pg8::TileOrder T; const char* A; const char* B;
    __device__ __forceinline__ bool next(int i, pg8::Unit& u) const { int pm, pn; if (!T.pmpn(i, pm, pn)) return false; u.pm = pm; u.pn = pn; u.aux = pn >> 1;
        u.A = A + ((size_t)pm * 256 * DM + (size_t)(pn >> 1) * PGC) * 2; u.B = B + ((size_t)(pn >> 1) * PGC * PGC + (size_t)(pn & 1) * 256 * PGC) * 2; return true; }
};
struct SchedMoe {
    pg8::TileOrder T; const char* A; const char* B; size_t astep, bstep, estep; volatile LAS unsigned* ts; int pm0;
    __device__ __forceinline__ bool next(int i, pg8::Unit& u) const { int pm, pn; if (!T.pmpn(i, pm, pn)) return false; pm += pm0; u.pm = pm; u.pn = pn;
        int e = 0;
#pragma unroll
        for (int k = 1; k < NE; ++k) e += ((unsigned)pm >= (unsigned)__builtin_amdgcn_readfirstlane((int)ts[k])) ? 1 : 0;
        u.aux = e; u.A = A + (size_t)pm * astep; u.B = B + (size_t)e * estep + (size_t)pn * bstep; return true; }
};

struct Args { const float* in[17]; float* out; unsigned char* ws; int ph_lo, ph_hi; };
constexpr int N_PHASES = 16;
__global__ void __launch_bounds__(NTHREADS, 2) fwd_kernel(Args args) {
    extern __shared__ __attribute__((aligned(16))) unsigned char lds[];
    Frame F;
    F.lds = (LAS unsigned char*)lds;
    F.MISC = (volatile LAS unsigned*)(F.lds + MISC_OFF);
    F.wave = __builtin_amdgcn_readfirstlane((int)(threadIdx.x >> 6));
    const int lane_ = lane_id(), tid_ = F.wave * 64 + lane_;
    F.G = gridDim.x; { const int bx = blockIdx.x; F.vcu = (F.G % 8 == 0) ? (bx % 8) * (F.G / 8) + bx / 8 : bx; }
    F.ws = args.ws; F.ctl = (unsigned*)(args.ws + WS_CTL);
    F.out = args.out;
    for (int u = tid_; u < (LDS_BYTES - LDSCTL_OFF) / 4; u += NTHREADS) ((LAS unsigned*)(F.lds + LDSCTL_OFF))[u] = 0u;
    if (tid_ < 17) { const unsigned long long pv = (unsigned long long)args.in[tid_]; F.MISC[64 + 2 * tid_] = (unsigned)pv; F.MISC[64 + 2 * tid_ + 1] = (unsigned)(pv >> 32); }
    __syncthreads();
    XcdBarrier bar; bar.bar = F.ctl + CW_BAR; bar.x = 0; bar.st = nullptr;
    if (MK_N_LAUNCHES == 1) bar = xcd_barrier_post(F.ctl + CW_BAR, F.MISC + 8, tid_ == 0);
    const int lo = args.ph_lo, hi = args.ph_hi;
#define IN(k) (lo <= (k) && (k) < hi)
#define REPS(k) for (int rep_ = 0; rep_ < ((PROBE_DUP == (k)) ? 2 : 1); ++rep_)
#define SEAM(k) do { if (IN(k) && IN((k) + 1)) xcd_barrier(bar, F.wave); } while (0)
    unsigned char* ws = args.ws;
    const char* XQ = (const char*)(ws + WS_XB); const bf16_t* XF = (const bf16_t*)(ws + WS_XF); bf16_t* U = (bf16_t*)args.out; const float* SX = (const float*)(ws + WS_SX);
    const int cid = (int)blockIdx.x;

    if (IN(0)) REPS(0) {
        convert_family(F, F.in(I_POOLW), PGC, PGC, (size_t)PGC * PGC, (bf16_t*)(ws + WS_WPOOL), (size_t)PGC * PGC, 4);
        down_scale_sample(F);
        __syncthreads();
        quant_weights(F);
        rope_tables(F);
        pool_diff(F);
    }
    SEAM(0);
    if (IN(1)) REPS(1) {
        SchedPool S; S.T.init(M / 256, DM / 256, F.G, cid); S.A = (const char*)(ws + WS_DIFF); S.B = (const char*)(ws + WS_WPOOL);
        pg8::EpiRes<true> E{(const void*)F.in(I_X), U, DM, F.in(I_POOLS), nullptr};
        pg8::gemm_phase<0, pg8::EpiRes<true>, SchedPool, true>(F.lds + RING_OFF, pg8::GemmP{PGC / 64, DM * 2, PGC * 2}, S, E, F.wave);
    }
    SEAM(1);
    if (IN(2)) REPS(2) { ln_phase(F, U, F.in(I_LMG), F.in(I_LMB)); __syncthreads();
        down_quant(F, F.lds + RING_OFF, F.in(I_FD), DFF, 1, (const float*)(ws + WS_SCL) + NE, ws + WS_WD, 0, ((DFF / 512) * (DM / 64) + F.G - 1) / F.G);
        down_quant(F, F.lds + RING_OFF, F.in(I_WO), DM, 1, (const float*)(ws + WS_SCL) + NE + 1, ws + WS_WO, 0, ((DM / 512) * (DM / 64) + F.G - 1) / F.G); }
    SEAM(2);
    if (IN(3)) REPS(3) {
        SchedDense S; S.T.init(M / 256, 2 * DFF / 256, F.G, cid); S.A = XQ; S.B = (const char*)(ws + WS_WGU); S.astep = (size_t)256 * DM; S.bstep = (size_t)256 * DM;
        pg8::EpiSwiGLU<true> E{(void*)(ws + WS_HFFN), DFF, SX, (const float*)(ws + WS_SWGU), 0};
        pg8::gemm_phase<1, pg8::EpiSwiGLU<true>, SchedDense, true>(F.lds + RING_OFF, pg8::GemmP{DM / 128, DM, DM}, S, E, F.wave);
    }
    SEAM(3);
    if (IN(4)) REPS(4) {
        SchedDense S; S.T.init(M / 256, DM / 256, F.G, cid, WGM_BIGK); S.A = (const char*)(ws + WS_HFFN); S.B = (const char*)(ws + WS_WD); S.astep = (size_t)256 * DFF; S.bstep = (size_t)256 * DFF;
        pg8::EpiRes<false> E{(const void*)XF, U, DM, nullptr, (const float*)(ws + WS_SCL) + NE};
        pg8::gemm_phase<2, pg8::EpiRes<false>, SchedDense, true>(F.lds + RING_OFF, pg8::GemmP{DFF / 128, DFF, DFF}, S, E, F.wave);
    }
    SEAM(4);
    if (IN(5)) REPS(5) ln_phase(F, U, F.in(I_LFG), F.in(I_LFB));
    SEAM(5);
    if (IN(6)) REPS(6) {
        SchedDense S; S.T.init(M / 256, 3 * DM / 256, F.G, cid); S.A = XQ; S.B = (const char*)(ws + WS_WQKV); S.astep = (size_t)256 * DM; S.bstep = (size_t)256 * DM;
        pg8::EpiQKV E{(bf16_t*)(ws + WS_Q), (bf16_t*)(ws + WS_K), (bf16_t*)(ws + WS_V), (const float*)(ws + WS_COS), (const float*)(ws + WS_SIN), SX, (const float*)(ws + WS_SWQKV), F.ctl + CW_VMAX};
        pg8::gemm_phase<1, pg8::EpiQKV, SchedDense, true>(F.lds + RING_OFF, pg8::GemmP{DM / 128, DM, DM}, S, E, F.wave);
    }
    SEAM(6);
    if (IN(7)) REPS(7) kmean_phase(F);
    SEAM(7);
    if (IN(8)) REPS(8) {
        struct MoeSide { Frame& F; __device__ __forceinline__ void operator()(int slot, int nslots) const { moe_side_work(F, slot, nslots); } };
        att::attn_phase((char*)lds + RING_OFF, ws, F.G, F.vcu, F.wave, MoeSide{F});
    }
    SEAM(8);
    if (IN(9)) REPS(9) {
        SchedDense S; S.T.init(M / 256, DM / 256, F.G, cid); S.A = (const char*)(ws + WS_O); S.B = (const char*)(ws + WS_WO); S.astep = (size_t)256 * DM; S.bstep = (size_t)256 * DM;
        pg8::EpiRes<false> E{(const void*)XF, U, DM, nullptr, (const float*)(ws + WS_SCL) + NE + 3};
        pg8::gemm_phase<2, pg8::EpiRes<false>, SchedDense, true>(F.lds + RING_OFF, pg8::GemmP{DM / 128, DM, DM}, S, E, F.wave);
    }
    SEAM(9);
    if (IN(10)) ln_router_phase(F, U, F.in(I_LMG) + DM, F.in(I_LMB) + DM);
    SEAM(10);
    if (IN(11)) REPS(11) { moe_layout(F); gather_phase(F); }
    SEAM(11);
    if (IN(12)) REPS(12) {
        moe_layout(F);
        SchedMoe S; S.T.init(__builtin_amdgcn_readfirstlane((int)F.MISC[32 + NE]), 2 * DFE / 256, F.G, cid); S.A = (const char*)(ws + WS_XS); S.B = (const char*)(ws + WS_MWGU);
        S.astep = (size_t)256 * DM; S.bstep = (size_t)256 * DM; S.estep = (size_t)2 * DFE * DM; S.ts = F.MISC + 32; S.pm0 = 0;
        pg8::EpiSwiGLU<true> E{(void*)(ws + WS_HMOE), DFE, (const float*)(ws + WS_SXS), (const float*)(ws + WS_SWM), 2 * DFE};
        pg8::gemm_phase<1, pg8::EpiSwiGLU<true>, SchedMoe, true>(F.lds + RING_OFF, pg8::GemmP{DM / 128, DM, DM}, S, E, F.wave);
    }
    SEAM(12);
    if (IN(13)) REPS(13) {
        moe_layout(F);
        const int nRT = __builtin_amdgcn_readfirstlane((int)F.MISC[32 + NE]), nRTa = (nRT / (F.G / 8)) * (F.G / 8);
        SchedMoe S; S.T.init(nRTa, DM / 256, F.G, cid, WGM_BIGK); S.A = (const char*)(ws + WS_HMOE); S.B = (const char*)(ws + WS_MWD);
        S.astep = (size_t)256 * DFE; S.bstep = (size_t)256 * DFE; S.estep = (size_t)DM * DFE; S.ts = F.MISC + 32; S.pm0 = 0;
        pg8::EpiBf16 E{(bf16_t*)(ws + WS_OE), DM, (const float*)(ws + WS_SCL)};
        pg8::gemm_phase<2, pg8::EpiBf16, SchedMoe, true>(F.lds + RING_OFF, pg8::GemmP{DFE / 128, DFE, DFE}, S, E, F.wave);
    }
    SEAM(13);
    if (IN(14)) REPS(14) {
        moe_layout(F);
        const int nRT = __builtin_amdgcn_readfirstlane((int)F.MISC[32 + NE]), nRTa = (nRT / (F.G / 8)) * (F.G / 8);
        if (cid < (nRT - nRTa) * (DM / 256)) {
            SchedMoe S; S.T.init(nRT - nRTa, DM / 256, F.G, cid, WGM_BIGK); S.A = (const char*)(ws + WS_HMOE); S.B = (const char*)(ws + WS_MWD);
            S.astep = (size_t)256 * DFE; S.bstep = (size_t)256 * DFE; S.estep = (size_t)DM * DFE; S.ts = F.MISC + 32; S.pm0 = nRTa;
            pg8::EpiBf16 E{(bf16_t*)(ws + WS_OE), DM, (const float*)(ws + WS_SCL)};
            pg8::gemm_phase<2, pg8::EpiBf16, SchedMoe, true>(F.lds + RING_OFF, pg8::GemmP{DFE / 128, DFE, DFE}, S, E, F.wave);
        } else final_phase(F, F.in(I_LFG) + DM, F.in(I_LFB) + DM, 0, nRTa * 256);
    }
    SEAM(14);
    if (IN(15)) REPS(15) final_phase(F, F.in(I_LFG) + DM, F.in(I_LFB) + DM, 1, 0);
#undef IN
#undef SEAM
}

extern "C" void kernel_launch(void* const* d_in, const int* in_sizes, int n_in, void* d_out, int out_size, void* d_ws, size_t ws_size, hipStream_t stream) {
    static int grid = 0;
    if (grid == 0) {
        if (n_in != 17 || in_sizes[0] != M * DM || out_size != M * DM || ws_size < WS_END) { fprintf(stderr, "kernel_launch: unexpected shapes (n_in %d, in0 %d, out %d, ws %zu); nothing launched\n", n_in, n_in > 0 ? in_sizes[0] : -1, out_size, ws_size); grid = -1; return; }
        int dev = 0, cus = 0, per_cu = 0;
        if (hipGetDevice(&dev) != hipSuccess || hipDeviceGetAttribute(&cus, hipDeviceAttributeMultiprocessorCount, dev) != hipSuccess) { grid = -1; return; }
        if (hipFuncSetAttribute((const void*)fwd_kernel, hipFuncAttributeMaxDynamicSharedMemorySize, LDS_BYTES) != hipSuccess) { fprintf(stderr, "kernel_launch: hipFuncSetAttribute failed\n"); grid = -1; return; }
        if (hipOccupancyMaxActiveBlocksPerMultiprocessor(&per_cu, (const void*)fwd_kernel, NTHREADS, LDS_BYTES) != hipSuccess || per_cu < 1) { fprintf(stderr, "kernel_launch: occupancy query says %d blocks per CU\n", per_cu); (void)hipGetLastError(); }
        grid = cus;
    }
    if (grid < 0) return;
    (void)hipMemsetAsync((char*)d_ws + WS_CTL, 0, CTL_ZERO_BYTES, stream);
    Args a{};
    for (int i = 0; i < 17; ++i) a.in[i] = (const float*)d_in[i];
    a.out = (float*)d_out; a.ws = (unsigned char*)d_ws;
#if MK_N_LAUNCHES == 1
    a.ph_lo = 0; a.ph_hi = N_PHASES;
    hipLaunchKernelGGL(fwd_kernel, dim3(grid), dim3(NTHREADS), LDS_BYTES, stream, a);
    if (PROBE_RELAUNCH >= 0) { a.ph_lo = PROBE_RELAUNCH; a.ph_hi = PROBE_RELAUNCH + 1; hipLaunchKernelGGL(fwd_kernel, dim3(grid), dim3(NTHREADS), LDS_BYTES, stream, a); }
#else
    for (int p = 0; p < N_PHASES; ++p) { a.ph_lo = p; a.ph_hi = p + 1; hipLaunchKernelGGL(fwd_kernel, dim3(grid), dim3(NTHREADS), LDS_BYTES, stream, a); }
#endif
}
```

```cpp
#include <hip/hip_runtime.h>
#include <cstdio>
#include <cstdint>

#define LAS __attribute__((address_space(3)))
#define GAS __attribute__((address_space(1)))
typedef unsigned short bf16_t;
typedef short bf16x8 __attribute__((ext_vector_type(8)));
typedef short s16x4 __attribute__((ext_vector_type(4)));
typedef float f32x2 __attribute__((ext_vector_type(2)));
typedef float f32x4 __attribute__((ext_vector_type(4)));
typedef float f32x16 __attribute__((ext_vector_type(16)));
typedef unsigned u32x2 __attribute__((ext_vector_type(2)));
typedef unsigned u32x4 __attribute__((ext_vector_type(4)));
typedef int i32x4 __attribute__((ext_vector_type(4)));
typedef int i32x8 __attribute__((ext_vector_type(8)));
typedef signed char i8_t;

#ifndef PROBE_DUP
#define PROBE_DUP -1
#endif
#ifndef PROBE_RELAUNCH
#define PROBE_RELAUNCH -1
#endif
#ifndef MK_N_LAUNCHES
#define MK_N_LAUNCHES 1
#endif

constexpr int NB = 4, SEQ = 4096, DM = 2048, NH = 16, HD = 128, M = NB * SEQ;
constexpr int DFF = 5632, NE = 8, DFE = 7168, NBLK = SEQ / 256, PGC = 512;
constexpr float ALPHA = 1.4142135623730951f, LN_EPS = 1e-5f;
constexpr int PMAX = 2 * M + NE * 256;
constexpr int NWAVES = 8, NTHREADS = 512;

constexpr size_t MiB = 1u << 20;
constexpr size_t WS_CTL = 0, CTL_ZERO_BYTES = 384 * 1024;
constexpr size_t WS_COS = 1 * MiB, WS_SIN = 2 * MiB;
constexpr size_t WS_KMEAN = 3 * MiB;
constexpr size_t WS_SCL = 3 * MiB + 512 * 1024;
constexpr size_t WS_TOKE = 4 * MiB, WS_TOKG = WS_TOKE + 128 * 1024, WS_TOKR = WS_TOKG + 128 * 1024, WS_TOKP = WS_TOKR + 128 * 1024;
constexpr size_t WS_SWQKV = 5 * MiB, WS_SWGU = WS_SWQKV + 32 * 1024, WS_SX = WS_SWQKV + 96 * 1024, WS_SXS = WS_SWQKV + 160 * 1024, WS_SWM = WS_SWQKV + 512 * 1024;
constexpr size_t WS_SWD = WS_SWQKV + 960 * 1024;
constexpr size_t WS_WPOOL = 6 * MiB;
constexpr size_t WS_WQKV = 8 * MiB;
constexpr size_t WS_WO = 32 * MiB;
constexpr size_t WS_WGU = 40 * MiB;
constexpr size_t WS_WD = 84 * MiB;
constexpr size_t WS_MWGU = 106 * MiB;
constexpr size_t WS_MWD = 554 * MiB;
constexpr size_t WS_XF = 778 * MiB;
constexpr size_t WS_XB = 906 * MiB;
constexpr size_t WS_XS = 970 * MiB;
constexpr size_t WS_OE = 1106 * MiB;
constexpr size_t WS_A = 1242 * MiB;
constexpr size_t WS_DIFF = WS_A, WS_HFFN = WS_A + 64 * MiB, WS_Q = WS_A + 240 * MiB, WS_K = WS_A + 304 * MiB, WS_V = WS_A + 368 * MiB, WS_O = WS_A + 432 * MiB;
constexpr size_t WS_HMOE = WS_A;
constexpr size_t WS_END = 1738 * MiB;
static_assert((size_t)PMAX * DFE * 2 <= 496 * MiB && (size_t)PMAX * DM * 2 <= 136 * MiB, "ws map");
constexpr int CW_TMO = 0, CW_CODE = 1;
constexpr int CW_CNT = 64;
constexpr int CW_VMAX = 80;
constexpr int CW_BAR = 4096;
constexpr int CW_DONE = 65536;
constexpr int CW_CMAX = 16384;

constexpr int RING_OFF = 0, RING_BYTES = 131072;
constexpr int LDS_BYTES = 147456;
constexpr int LDSCTL_OFF = LDS_BYTES - 2048, MISC_OFF = LDSCTL_OFF + 320;
static_assert(75776 + 32 * 2064 + 1024 <= LDSCTL_OFF, "LDS map");
constexpr int SIDE_OFF = 75776;

#define RLX_AGENT __ATOMIC_RELAXED, __HIP_MEMORY_SCOPE_AGENT
#define LDS_WAIT() asm volatile("s_waitcnt lgkmcnt(0)" ::: "memory")
#define VM_WAIT() asm volatile("s_waitcnt vmcnt(0)" ::: "memory")

__device__ __forceinline__ unsigned cvt_pk_bf16(float lo, float hi) { unsigned r; asm volatile("v_cvt_pk_bf16_f32 %0, %1, %2" : "=v"(r) : "v"(lo), "v"(hi)); return r; }
__device__ __forceinline__ float bf2f(unsigned short b) { return __uint_as_float((unsigned)b << 16); }
__device__ __forceinline__ int lane_id() { int l; asm volatile("v_mbcnt_lo_u32_b32 %0, -1, 0\n\tv_mbcnt_hi_u32_b32 %0, -1, %0" : "=v"(l)); return l; }
__device__ __forceinline__ float wave_sum(float v) {
#pragma unroll
    for (int o = 1; o < 64; o <<= 1) v += __shfl_xor(v, o);
    return v;
}

__device__ __forceinline__ float quad_xor1(float v) { return __int_as_float(__builtin_amdgcn_update_dpp(0, __float_as_int(v), 0xB1, 0xf, 0xf, false)); }
__device__ __forceinline__ float quad_xor2(float v) { return __int_as_float(__builtin_amdgcn_update_dpp(0, __float_as_int(v), 0x4E, 0xf, 0xf, false)); }
__device__ __forceinline__ float wave_max(float v) {
#pragma unroll
    for (int o = 1; o < 64; o <<= 1) v = fmaxf(v, __shfl_xor(v, o));
    return v;
}
__device__ __forceinline__ unsigned pack_i8x4(float a, float b, float c, float d) {
    const unsigned ua = __float_as_uint(a + 12582912.f), ub = __float_as_uint(b + 12582912.f), uc = __float_as_uint(c + 12582912.f), ud = __float_as_uint(d + 12582912.f);
    return __builtin_amdgcn_perm(ub, ua, 0x0c0c0400u) | __builtin_amdgcn_perm(ud, uc, 0x04000c0cu);
}

#define XB_TMO      128
#define XB_XCNT(j)  (256  + 64 * (j))
#define XB_XSUB(j)  (1280 + 64 * (j))
#define XB_XGEN(j)  (2304 + 64 * (j))
#define XB_TOP      3328
#define XB_TOPGEN   3392
#define XCD_BAR_WORDS 3456
#define XB_SPIN_CAP (1u << 20)
__device__ __forceinline__ unsigned xb_ld(unsigned* p)              { return __hip_atomic_load(p, __ATOMIC_RELAXED, __HIP_MEMORY_SCOPE_AGENT); }
__device__ __forceinline__ unsigned xb_add(unsigned* p, unsigned v) { return __hip_atomic_fetch_add(p, v, __ATOMIC_RELAXED, __HIP_MEMORY_SCOPE_AGENT); }
__device__ __forceinline__ unsigned xb_xcc_id() { return (unsigned)__builtin_amdgcn_s_getreg((3 << 11) | 20) & 0xFu; }
#define XB_SPIN(cond, bar) do { unsigned _sp = 0; while (cond) { __builtin_amdgcn_s_sleep(1); \
    if ((++_sp & 255u) == 0u) { if (xb_ld(&(bar)[XB_TMO])) break; if (_sp > XB_SPIN_CAP) { atomicAdd(&(bar)[XB_TMO], 1u); break; } } } } while (0)
struct XcdBarrier { unsigned* bar; unsigned x; volatile LAS unsigned* st; };
__device__ __forceinline__ XcdBarrier xcd_barrier_post(unsigned* bar, volatile LAS unsigned* st, bool leader) {
    XcdBarrier b; b.bar = bar; b.x = xb_xcc_id(); b.st = st;
    if (leader) (void)xb_add(&bar[XB_XCNT(b.x)], 1u);
    return b;
}
__device__ __forceinline__ void xcd_barrier_complete(unsigned* bar, unsigned x, unsigned& nloc, unsigned& nx) {
    const unsigned G = gridDim.x * gridDim.y * gridDim.z;
    unsigned sum, cnt, mine, sp = 0u;
    for (;;) {
        sum = 0u; cnt = 0u; mine = 0u;
#pragma unroll
        for (unsigned j = 0; j < 16; ++j) { const unsigned c = xb_ld(&bar[XB_XCNT(j)]); sum += c; cnt += (c > 0u) ? 1u : 0u; mine = (j == x) ? c : mine; }
        if (sum == G) break;
        __builtin_amdgcn_s_sleep(1);
        if ((++sp & 255u) == 0u) { if (xb_ld(&bar[XB_TMO])) break; if (sp > XB_SPIN_CAP) { atomicAdd(&bar[XB_TMO], 1u); break; } }
    }
    nloc = mine > 0u ? mine : 1u; nx = cnt > 0u ? cnt : 1u;
}
__device__ __forceinline__ void xcd_barrier(const XcdBarrier& b, int wave) {
    asm volatile("s_waitcnt vmcnt(0)" ::: "memory");
    __syncthreads();
    if (wave == 0 && lane_id() == 0) {
        unsigned* bar = b.bar;
        __builtin_amdgcn_s_waitcnt(0);
        unsigned nloc = b.st[0], nx = b.st[1];
        if (nloc == 0u) { xcd_barrier_complete(bar, b.x, nloc, nx); b.st[0] = nloc; b.st[1] = nx; }
        const unsigned old = xb_add(&bar[XB_XSUB(b.x)], 1u);
        const unsigned gen = old / nloc;
        if (old + 1u == (gen + 1u) * nloc) {
            __builtin_amdgcn_fence(__ATOMIC_RELEASE, "agent");
            asm volatile("s_waitcnt vmcnt(0)" ::: "memory");
            const unsigned og = xb_add(&bar[XB_TOP], 1u);
            const unsigned tg = og / nx;
            if (og + 1u == (tg + 1u) * nx) xb_add(&bar[XB_TOPGEN], 1u);
            else XB_SPIN(xb_ld(&bar[XB_TOPGEN]) == tg, bar);
            __builtin_amdgcn_fence(__ATOMIC_ACQUIRE, "agent");
            xb_add(&bar[XB_XGEN(b.x)], 1u);
            asm volatile("s_waitcnt vmcnt(0)" ::: "memory");
        } else {
            XB_SPIN(xb_ld(&bar[XB_XGEN(b.x)]) == gen, bar);
            __builtin_amdgcn_fence(__ATOMIC_ACQUIRE, "agent");
            asm volatile("s_waitcnt vmcnt(0)" ::: "memory");
        }
    }
    __syncthreads();
}

namespace pg8 {
constexpr int BM = 256, BK = 64, HALF = 128, HTB = HALF * BK * 2, STAGE_BYTES = 8 * HTB, NXCD = 8;
#ifndef PG8_B_AUX
#define PG8_B_AUX 0
#endif
#ifndef WGM_BIGK
#define WGM_BIGK 4
#endif
#ifndef PG8_WGM
#define PG8_WGM 4
#endif
constexpr int WGM = PG8_WGM;
__host__ __device__ __forceinline__ int lds_byte(int r, int c) { const int st = (r >> 4) * 2 + (c >> 5), rr = r & 15, cc = c & 31, ob = rr * 64 + cc * 2; return st * 1024 + (ob ^ (((ob >> 9) & 1) << 5)); }
__host__ __device__ __forceinline__ void stage_rc(int b, int& R, int& C) { const int st = b / 1024, sb = b % 1024, swz = sb ^ (((sb >> 9) & 1) << 5); R = (st >> 1) * 16 + swz / 64; C = (st & 1) * 32 + (swz % 64) / 2; }
__host__ __device__ __forceinline__ int perm32(int rho) { const int n = rho >> 4, i = rho & 15; return 8 * (i >> 2) + 4 * n + (i & 3); }

__device__ __forceinline__ void glds16_s(const char* sbase, unsigned voff, unsigned lds_dst) {
    unsigned keep;
    asm volatile("s_mov_b32 %0, m0\n\ts_mov_b32 m0, %3\n\ts_nop 0\n\tglobal_load_lds_dwordx4 %1, %2\n\ts_mov_b32 m0, %0" : "=&s"(keep) : "v"(voff), "s"(sbase), "s"(lds_dst) : "memory");
}
struct Unit { const char* A; const char* B; int pm, pn, aux; };
struct GemmP { int nt; unsigned lda, ldb; };
template <int DT> struct AccOf { typedef f32x4 T; };
template <> struct AccOf<1> { typedef i32x4 T; };
__device__ __forceinline__ f32x4 tof(f32x4 v) { return v; }
__device__ __forceinline__ f32x4 tof(i32x4 v) { return __builtin_convertvector(v, f32x4); }

struct TileOrder {
    int nM, nN, nwg, G, c, wgm;
    __device__ __forceinline__ void init(int nM_, int nN_, int G_, int c_, int wgm_ = WGM) { nM = nM_; nN = nN_; nwg = nM * nN; G = G_; c = c_; wgm = wgm_; }
    __device__ __forceinline__ bool pmpn(int i, int& pm, int& pn) const {
        const long L = (long)i * G + c; if (L >= nwg) return false;
        int wgid = (int)L; { const int q = nwg / NXCD, r = nwg % NXCD, xcd = wgid % NXCD, off = wgid / NXCD; wgid = (xcd < r ? xcd * (q + 1) : r * (q + 1) + (xcd - r) * q) + off; }
        const int nig = wgm * nN, gid = wgid / nig, fm = gid * wgm, gsz = (nM - fm) < wgm ? (nM - fm) : wgm;
        pm = __builtin_amdgcn_readfirstlane(fm + ((wgid % nig) % gsz)); pn = __builtin_amdgcn_readfirstlane((wgid % nig) / gsz); return true;
    }
};

template <int DT, class Epi, class Sched, bool ALIGN_EPI>
__device__ __forceinline__ void gemm_phase(LAS unsigned char* lds, const GemmP g, const Sched& S, const Epi& E, const int wid) {
    typedef typename AccOf<DT>::T AccT;
    const int lane = lane_id(), tid = wid * 64 + lane, wr = wid >> 2, wc = wid & 3, fr = lane & 15, fq = lane >> 4;
    const int nt = g.nt;
    unsigned voffA[2], voffB[2];
#pragma unroll
    for (int i = 0; i < 2; ++i) { int R, C; stage_rc(tid * 16 + i * 8192, R, C); const int Rb = Epi::PERM ? ((R & ~31) + perm32(R & 31)) : R;
        voffA[i] = (unsigned)R * g.lda + (unsigned)C * 2u; voffB[i] = (unsigned)Rb * g.ldb + (unsigned)C * 2u; }
    const size_t kstep = (size_t)(BK * 2);
    const size_t hstepA = (size_t)HALF * g.lda, hstepB = (size_t)HALF * g.ldb;
    const unsigned ldsw = (unsigned)wid * 1024u;
    const unsigned ldsb = (unsigned)__builtin_amdgcn_readfirstlane((int)((unsigned)(uintptr_t)lds + (unsigned)wid * 1024u));
    const int aoff = lds_byte(wr * 64 + fr, fq * 8), boff = lds_byte(wc * 32 + fr, fq * 8);
#define PG8_SA(b, h) (((b) * 2 + (h)) * HTB)
#define PG8_SB(b, h) ((4 + (b) * 2 + (h)) * HTB)
#define PG8_STAGE_(bufoff, gbase, voff, AUX) do { _Pragma("unroll") for (int _i = 0; _i < 2; ++_i) { \
        if constexpr (DT == 2) glds16_s((const char*)(gbase), (voff)[_i], ldsb + (unsigned)((bufoff) + _i * 8192)); \
        else __builtin_amdgcn_global_load_lds((const unsigned*)((const char*)(gbase) + (voff)[_i]), (LAS unsigned*)(lds + (bufoff) + ldsw + _i * 8192), 16, 0, AUX); } } while (0)
#define PG8_STAGE(bufoff, gbase, voff) PG8_STAGE_(bufoff, gbase, voff, 0)
#define PG8_STAGEB(bufoff, gbase, voff) PG8_STAGE_(bufoff, gbase, voff, PG8_B_AUX)
#define PG8_LDA(dst, b, h) do { _Pragma("unroll") for (int m = 0; m < 4; ++m) _Pragma("unroll") for (int k = 0; k < 2; ++k) dst[m][k] = *(const LAS bf16x8*)(lds + PG8_SA(b, h) + aoff + m * 2048 + k * 1024); } while (0)
#define PG8_LDB(dst, b, h) do { _Pragma("unroll") for (int n = 0; n < 2; ++n) _Pragma("unroll") for (int k = 0; k < 2; ++k) dst[n][k] = *(const LAS bf16x8*)(lds + PG8_SB(b, h) + boff + n * 2048 + k * 1024); } while (0)
#define PG8_MMA(ai, bj, At, Bt) do { __builtin_amdgcn_s_setprio(1); _Pragma("unroll") for (int m = 0; m < 4; ++m) _Pragma("unroll") for (int n = 0; n < 2; ++n) { \
        if constexpr (DT == 0) { _Pragma("unroll") for (int k = 0; k < 2; ++k) acc[ai][bj][m][n] = __builtin_amdgcn_mfma_f32_16x16x32_bf16(Bt[n][k], At[m][k], acc[ai][bj][m][n], 0, 0, 0); } \
        else if constexpr (DT == 1) { _Pragma("unroll") for (int k = 0; k < 2; ++k) acc[ai][bj][m][n] = __builtin_amdgcn_mfma_i32_16x16x64_i8(__builtin_bit_cast(i32x4, Bt[n][k]), __builtin_bit_cast(i32x4, At[m][k]), acc[ai][bj][m][n], 0, 0, 0); } \
        else { const i32x4 b0_ = __builtin_bit_cast(i32x4, Bt[n][0]), b1_ = __builtin_bit_cast(i32x4, Bt[n][1]), a0_ = __builtin_bit_cast(i32x4, At[m][0]), a1_ = __builtin_bit_cast(i32x4, At[m][1]); \
            acc[ai][bj][m][n] = __builtin_amdgcn_mfma_scale_f32_16x16x128_f8f6f4((i32x8){b0_[0], b0_[1], b0_[2], b0_[3], b1_[0], b1_[1], b1_[2], b1_[3]}, (i32x8){a0_[0], a0_[1], a0_[2], a0_[3], a1_[0], a1_[1], a1_[2], a1_[3]}, acc[ai][bj][m][n], 0, 0, 0, 0, 0, 0); } } \
        __builtin_amdgcn_s_setprio(0); } while (0)
#define PG8_WAIT_V(n) asm volatile("s_waitcnt vmcnt(" #n ")" ::: "memory")
#define PG8_WAIT_L(n) asm volatile("s_waitcnt lgkmcnt(" #n ")" ::: "memory")
#define PG8_BAR __builtin_amdgcn_s_barrier()
#define PG8_SCHED __builtin_amdgcn_sched_barrier(0)
    Unit cur, nxt; int ui = 0;
    if (!S.next(0, cur)) return;
    AccT acc[2][2][4][2];
#pragma unroll
    for (int a = 0; a < 2; ++a)
#pragma unroll
        for (int b = 0; b < 2; ++b)
#pragma unroll
            for (int m = 0; m < 4; ++m)
#pragma unroll
                for (int n = 0; n < 2; ++n) acc[a][b][m][n] = (AccT){0, 0, 0, 0};
    bf16x8 At[4][2], B0[2][2], B1[2][2];
    const char* cA = cur.A; const char* cB = cur.B;
    PG8_STAGEB(PG8_SB(0, 0), cB, voffB); PG8_STAGEB(PG8_SB(0, 1), cB + hstepB, voffB); PG8_STAGE(PG8_SA(0, 0), cA, voffA); PG8_STAGE(PG8_SA(0, 1), cA + hstepA, voffA);
    if (wr == 1) PG8_BAR;
    PG8_WAIT_V(2); PG8_BAR;
    PG8_STAGEB(PG8_SB(1, 0), cB + kstep, voffB); PG8_STAGE(PG8_SA(1, 0), cA + kstep, voffA); PG8_STAGEB(PG8_SB(1, 1), cB + hstepB + kstep, voffB);
    PG8_WAIT_V(6); PG8_BAR;
    for (;;) {
        const bool has_next = S.next(ui + 1, nxt);
        const char* nA = has_next ? nxt.A : cA; const char* nB = has_next ? nxt.B : cB;
        for (int t = 0; t < nt; t += 2) {
            const bool last = (t == nt - 2);
            const char* a1 = cA + (size_t)(t + 1) * kstep;
            const char* a2 = last ? nA : cA + (size_t)(t + 2) * kstep; const char* b2 = last ? nB : cB + (size_t)(t + 2) * kstep;
            const char* a3 = a2 + kstep; const char* b3 = b2 + kstep;
            PG8_LDB(B0, 0, 0); PG8_LDB(B1, 0, 1); PG8_SCHED; PG8_LDA(At, 0, 0); PG8_STAGE(PG8_SA(1, 1), a1 + hstepA, voffA);
            PG8_WAIT_V(8); PG8_WAIT_L(0); PG8_BAR; PG8_MMA(0, 0, At, B0); PG8_MMA(0, 1, At, B1); PG8_BAR; PG8_SCHED;
            PG8_LDA(At, 0, 1); PG8_STAGEB(PG8_SB(0, 0), b2, voffB); PG8_STAGEB(PG8_SB(0, 1), b2 + hstepB, voffB); PG8_STAGE(PG8_SA(0, 0), a2, voffA);
            PG8_WAIT_V(8); PG8_WAIT_L(0); PG8_BAR; PG8_MMA(1, 0, At, B0); PG8_MMA(1, 1, At, B1); PG8_BAR; PG8_SCHED;
            PG8_LDB(B0, 1, 0); PG8_LDB(B1, 1, 1); PG8_SCHED; PG8_LDA(At, 1, 0); PG8_STAGE(PG8_SA(0, 1), a2 + hstepA, voffA);
            PG8_WAIT_V(8); PG8_WAIT_L(0); PG8_BAR; PG8_MMA(0, 0, At, B0); PG8_MMA(0, 1, At, B1); PG8_BAR; PG8_SCHED;
            PG8_LDA(At, 1, 1); PG8_STAGEB(PG8_SB(1, 0), b3, voffB); PG8_STAGEB(PG8_SB(1, 1), b3 + hstepB, voffB); PG8_STAGE(PG8_SA(1, 0), a3, voffA);
            PG8_WAIT_V(8); PG8_WAIT_L(0); PG8_BAR; PG8_MMA(1, 0, At, B0); PG8_MMA(1, 1, At, B1); PG8_BAR; PG8_SCHED;
        }
        if constexpr (ALIGN_EPI) { if (wr == 0) PG8_BAR; }
        { const int le = lane_id(); E(acc, cur, wr, wc, le & 15, le >> 4); }
        if (!has_next) break;
#pragma unroll
        for (int a = 0; a < 2; ++a)
#pragma unroll
            for (int b = 0; b < 2; ++b)
#pragma unroll
                for (int m = 0; m < 4; ++m)
#pragma unroll
                    for (int n = 0; n < 2; ++n) acc[a][b][m][n] = (AccT){0, 0, 0, 0};
        cur = nxt; cA = nA; cB = nB; ++ui;
        if constexpr (ALIGN_EPI) { if (wr == 1) PG8_BAR; }
    }
    PG8_WAIT_V(0);
    if constexpr (!ALIGN_EPI) { if (wr == 0) PG8_BAR; }
    PG8_BAR;
#undef PG8_SA
#undef PG8_SB
#undef PG8_STAGE
#undef PG8_STAGEB
#undef PG8_STAGE_
#undef PG8_LDA
#undef PG8_LDB
#undef PG8_MMA
#undef PG8_WAIT_V
#undef PG8_WAIT_L
#undef PG8_BAR
#undef PG8_SCHED
}

__device__ __forceinline__ void unpack_bf16x8(const u32x4 w, f32x4& a, f32x4& b) {
    a[0] = __uint_as_float(w.x << 16); a[1] = __uint_as_float(w.x & 0xffff0000u); a[2] = __uint_as_float(w.y << 16); a[3] = __uint_as_float(w.y & 0xffff0000u);
    b[0] = __uint_as_float(w.z << 16); b[1] = __uint_as_float(w.z & 0xffff0000u); b[2] = __uint_as_float(w.w << 16); b[3] = __uint_as_float(w.w & 0xffff0000u);
}
template <bool RES_F32> struct EpiRes {
    static constexpr bool PERM = true;
    const void* res; bf16_t* out; int ldc; const float* colscale; const float* scl;
    template <class AccT> __device__ __forceinline__ void operator()(const AccT (&acc)[2][2][4][2], const Unit& u, int wr, int wc, int fr, int fq) const {
        const int row0 = u.pm * BM + wr * 64 + fr, col0 = u.pn * BM + wc * 32 + 8 * fq;
        const float cinv = scl ? 1.0f / *scl : 1.0f;
        f32x4 cs[2][2];
#pragma unroll
        for (int bj = 0; bj < 2; ++bj)
#pragma unroll
            for (int n = 0; n < 2; ++n) cs[bj][n] = colscale ? *(const f32x4*)(colscale + col0 + bj * HALF + n * 4) * cinv : (f32x4){cinv, cinv, cinv, cinv};
#pragma unroll
        for (int ai = 0; ai < 2; ++ai)
#pragma unroll
            for (int m = 0; m < 4; ++m) { const size_t off = (size_t)(row0 + ai * HALF + m * 16) * ldc + col0;
#pragma unroll
                for (int bj = 0; bj < 2; ++bj) { f32x4 r0, r1;
                    if constexpr (RES_F32) { r0 = *(const f32x4*)((const float*)res + off + bj * HALF); r1 = *(const f32x4*)((const float*)res + off + bj * HALF + 4); }
                    else unpack_bf16x8(*(const u32x4*)((const bf16_t*)res + off + bj * HALF), r0, r1);
                    const f32x4 v0 = r0 * ALPHA + tof(acc[ai][bj][m][0]) * cs[bj][0], v1 = r1 * ALPHA + tof(acc[ai][bj][m][1]) * cs[bj][1];
                    u32x4 w; w.x = cvt_pk_bf16(v0[0], v0[1]); w.y = cvt_pk_bf16(v0[2], v0[3]); w.z = cvt_pk_bf16(v1[0], v1[1]); w.w = cvt_pk_bf16(v1[2], v1[3]);
                    *(u32x4*)(out + off + bj * HALF) = w; } }
    }
};
__device__ __forceinline__ float silu_mul(float g, float u) { return g * __builtin_amdgcn_rcpf(1.0f + __builtin_amdgcn_exp2f(-1.4426950408889634f * g)) * u; }
template <bool OUT8> struct EpiSwiGLU {
    static constexpr bool PERM = true;
    void* H; int ldh; const float* sx; const float* sw; int sw_estride;
    template <class AccT> __device__ __forceinline__ void operator()(const AccT (&acc)[2][2][4][2], const Unit& u, int wr, int wc, int fr, int fq) const {
        const int row0 = u.pm * BM + wr * 64 + fr, col0 = u.pn * HALF + wc * 32 + 8 * fq;
        const float* swp = sw + (size_t)u.aux * sw_estride + u.pn * BM + wc * 32 + 8 * fq;
        const f32x4 wg0 = *(const f32x4*)swp, wg1 = *(const f32x4*)(swp + 4), wu0 = *(const f32x4*)(swp + HALF), wu1 = *(const f32x4*)(swp + HALF + 4);
#pragma unroll
        for (int ai = 0; ai < 2; ++ai)
#pragma unroll
            for (int m = 0; m < 4; ++m) { const int r = row0 + ai * HALF + m * 16; const float sr = sx[r];
                const f32x4 g0 = tof(acc[ai][0][m][0]) * (wg0 * sr), g1 = tof(acc[ai][0][m][1]) * (wg1 * sr), u0 = tof(acc[ai][1][m][0]) * (wu0 * sr), u1 = tof(acc[ai][1][m][1]) * (wu1 * sr);
                f32x4 e0 = g0 * -1.4426950408889634f, e1 = g1 * -1.4426950408889634f;
#pragma unroll
                for (int i = 0; i < 4; ++i) { e0[i] = __builtin_amdgcn_exp2f(e0[i]); e1[i] = __builtin_amdgcn_exp2f(e1[i]); }
                e0 = e0 + 1.0f; e1 = e1 + 1.0f;
#pragma unroll
                for (int i = 0; i < 4; ++i) { e0[i] = __builtin_amdgcn_rcpf(e0[i]); e1[i] = __builtin_amdgcn_rcpf(e1[i]); }
                const f32x4 h0 = (g0 * u0) * e0, h1 = (g1 * u1) * e1;
                const float h[8] = {h0[0], h0[1], h0[2], h0[3], h1[0], h1[1], h1[2], h1[3]};
                if constexpr (OUT8) {
                    int p0 = __builtin_amdgcn_cvt_pk_fp8_f32(h[0], h[1], 0, false); p0 = __builtin_amdgcn_cvt_pk_fp8_f32(h[2], h[3], p0, true);
                    int p1 = __builtin_amdgcn_cvt_pk_fp8_f32(h[4], h[5], 0, false); p1 = __builtin_amdgcn_cvt_pk_fp8_f32(h[6], h[7], p1, true);
                    *(u32x2*)((unsigned char*)H + (size_t)r * ldh + col0) = (u32x2){(unsigned)p0, (unsigned)p1};
                } else {
                    u32x4 w; w.x = cvt_pk_bf16(h[0], h[1]); w.y = cvt_pk_bf16(h[2], h[3]); w.z = cvt_pk_bf16(h[4], h[5]); w.w = cvt_pk_bf16(h[6], h[7]);
                    *(u32x4*)((bf16_t*)H + (size_t)r * ldh + col0) = w; } }
    }
};
struct EpiBf16 {
    static constexpr bool PERM = true;
    bf16_t* O; int ldc; const float* scl;
    template <class AccT> __device__ __forceinline__ void operator()(const AccT (&acc)[2][2][4][2], const Unit& u, int wr, int wc, int fr, int fq) const {
        const int row0 = u.pm * BM + wr * 64 + fr, col0 = u.pn * BM + wc * 32 + 8 * fq;
        const float cinv = scl ? 1.0f / scl[u.aux] : 1.0f;
#pragma unroll
        for (int ai = 0; ai < 2; ++ai)
#pragma unroll
            for (int m = 0; m < 4; ++m) { bf16_t* rowp = O + (size_t)(row0 + ai * HALF + m * 16) * ldc + col0;
#pragma unroll
                for (int bj = 0; bj < 2; ++bj) { const f32x4 v0 = tof(acc[ai][bj][m][0]) * cinv, v1 = tof(acc[ai][bj][m][1]) * cinv;
                    u32x4 w; w.x = cvt_pk_bf16(v0[0], v0[1]); w.y = cvt_pk_bf16(v0[2], v0[3]); w.z = cvt_pk_bf16(v1[0], v1[1]); w.w = cvt_pk_bf16(v1[2], v1[3]);
                    *(u32x4*)(rowp + bj * HALF) = w; } }
    }
};
struct EpiQKV {
    static constexpr bool PERM = true;
    bf16_t* Q; bf16_t* Kd; bf16_t* V; const float* cs; const float* sn; const float* sx; const float* sw; unsigned* vmax;
    template <class AccT> __device__ __forceinline__ void operator()(const AccT (&acc)[2][2][4][2], const Unit& u, int wr, int wc, int fr, int fq) const {
        const int row0 = u.pm * BM + wr * 64 + fr;
        const float* swp = sw + u.pn * BM + wc * 32 + 8 * fq;
        const f32x4 w00 = *(const f32x4*)swp, w01 = *(const f32x4*)(swp + 4), w10 = *(const f32x4*)(swp + HALF), w11 = *(const f32x4*)(swp + HALF + 4);
        if (u.pn >= 16) {
            const int dcol = wc * 32 + 8 * fq;
            f32x4 vm = (f32x4){0.f, 0.f, 0.f, 0.f};
#pragma unroll
            for (int ai = 0; ai < 2; ++ai)
#pragma unroll
                for (int m = 0; m < 4; ++m) { const int r = row0 + ai * HALF + m * 16, b = r >> 12, s = r & (SEQ - 1); const float sr = sx[r];
#pragma unroll
                    for (int bj = 0; bj < 2; ++bj) { const int h = 2 * (u.pn - 16) + bj; const f32x4 v0 = tof(acc[ai][bj][m][0]) * ((bj ? w10 : w00) * sr), v1 = tof(acc[ai][bj][m][1]) * ((bj ? w11 : w01) * sr);
                        vm = __builtin_elementwise_max(vm, __builtin_elementwise_max(__builtin_elementwise_abs(v0), __builtin_elementwise_abs(v1)));
                        u32x4 w; w.x = cvt_pk_bf16(v0[0], v0[1]); w.y = cvt_pk_bf16(v0[2], v0[3]); w.z = cvt_pk_bf16(v1[0], v1[1]); w.w = cvt_pk_bf16(v1[2], v1[3]);
                        *(u32x4*)(V + ((size_t)(b * NH + h) * SEQ + s) * HD + dcol) = w; } }
            const float t = wave_max(fmaxf(fmaxf(vm[0], vm[1]), fmaxf(vm[2], vm[3])));
            if (lane_id() == 0) __hip_atomic_fetch_max(vmax, __float_as_uint(t), __ATOMIC_RELAXED, __HIP_MEMORY_SCOPE_AGENT);
        } else {
            bf16_t* dst = (u.pn >= 8) ? Kd : Q;
            const int h = 2 * (u.pn & 7) + (wc >> 1), dlo = (wc & 1) * 32 + 8 * fq;
#pragma unroll
            for (int ai = 0; ai < 2; ++ai)
#pragma unroll
                for (int m = 0; m < 4; ++m) { const int r = row0 + ai * HALF + m * 16, b = r >> 12, s = r & (SEQ - 1); const float sr = sx[r];
                    const f32x4 c0 = *(const f32x4*)(cs + s * 64 + dlo), c1 = *(const f32x4*)(cs + s * 64 + dlo + 4), s0 = *(const f32x4*)(sn + s * 64 + dlo), s1 = *(const f32x4*)(sn + s * 64 + dlo + 4);
                    const f32x4 l0 = tof(acc[ai][0][m][0]) * (w00 * sr), l1 = tof(acc[ai][0][m][1]) * (w01 * sr), h0 = tof(acc[ai][1][m][0]) * (w10 * sr), h1 = tof(acc[ai][1][m][1]) * (w11 * sr);
                    const f32x4 ol0 = l0 * c0 - h0 * s0, ol1 = l1 * c1 - h1 * s1, oh0 = h0 * c0 + l0 * s0, oh1 = h1 * c1 + l1 * s1;
                    bf16_t* p = dst + ((size_t)(b * NH + h) * SEQ + s) * HD + dlo;
                    u32x4 w; w.x = cvt_pk_bf16(ol0[0], ol0[1]); w.y = cvt_pk_bf16(ol0[2], ol0[3]); w.z = cvt_pk_bf16(ol1[0], ol1[1]); w.w = cvt_pk_bf16(ol1[2], ol1[3]);
                    *(u32x4*)p = w;
                    w.x = cvt_pk_bf16(oh0[0], oh0[1]); w.y = cvt_pk_bf16(oh0[2], oh0[3]); w.z = cvt_pk_bf16(oh1[0], oh1[1]); w.w = cvt_pk_bf16(oh1[2], oh1[3]);
                    *(u32x4*)(p + 64) = w; }
        }
    }
};
}

namespace att {
constexpr int D = 128, NW = 8, QBLK = 32, KVBLK = 64, QB = 256, LDO = DM;
constexpr float SCALE = 0.08838834764831845f;
constexpr int SHM_V = KVBLK * D * 2, SHM_K = KVBLK * D * 2;
constexpr int OFF_WS = 2 * SHM_V + 2 * SHM_K, OFF_KM = OFF_WS + NW * 64 * 4, LDS_BYTES = OFF_KM + 8192;
#define KSWZ(row, colB) ((row) * 256 + ((colB) ^ (((row) & 7) << 4)))
#define SBAR() __builtin_amdgcn_sched_barrier(0)
__device__ __forceinline__ int v_st(int k, int c) { const int kk = (k & ~0xC) | ((k & 4) << 1) | ((k & 8) >> 1); return ((kk >> 3) * 4 + (c >> 5)) * 512 + ((kk & 7) * 32 + (c & 31)) * 2; }
__device__ __forceinline__ int v_rd_base(int lane) { return ((lane & 3) << 3) | (((lane >> 2) & 3) << 6) | (((lane >> 4) & 1) << 5) | (((lane >> 5) & 1) << 8); }
constexpr int v_rd_off(int d0, int ks, int half) { return d0 * 512 + ks * 4096 + half * 2048; }
__device__ __forceinline__ int crow(int r, int hi) { return (r & 3) + 8 * (r >> 2) + 4 * hi; }
__device__ __forceinline__ bf16x8 load8(const bf16_t* p) { return *reinterpret_cast<const bf16x8*>(p); }
__device__ __forceinline__ void mask_tile(f32x16& p0, f32x16& p1, int dq) {
    const float NEG = -__builtin_inff();
#pragma unroll
    for (int r = 0; r < 16; ++r) {
        const int c = (r & 3) + 8 * (r >> 2);
        if (dq - c < 0) p0[r] = NEG;
        if (dq - c - 32 < 0) p1[r] = NEG;
    }
}
__device__ __forceinline__ void mask_all(f32x16& p0, f32x16& p1) {
    const float NEG = -__builtin_inff();
#pragma unroll
    for (int r = 0; r < 16; ++r) { p0[r] = NEG; p1[r] = NEG; }
}
constexpr float THR = 8.f;
__device__ __forceinline__ void partialSM(f32x16& p0, f32x16& p1, float& m_reg, float& mn, float& alpha, const bool rowmask) {
    float pmax = p0[0];
#pragma unroll
    for (int r = 1; r < 16; ++r) pmax = fmaxf(pmax, p0[r]);
#pragma unroll
    for (int r = 0; r < 16; ++r) pmax = fmaxf(pmax, p1[r]);
    { auto rr = __builtin_amdgcn_permlane32_swap(__float_as_uint(pmax), __float_as_uint(pmax), false, false);
      pmax = fmaxf(__uint_as_float(rr[0]), __uint_as_float(rr[1])); }
    constexpr float C2 = 1.4426950408889634f * SCALE;
    pmax = rowmask ? -__builtin_inff() : pmax;
    if (__builtin_expect(__all((pmax - m_reg) * SCALE <= THR), 1)) { mn = m_reg; alpha = 1.f; }
    else { mn = fmaxf(m_reg, pmax); alpha = __builtin_amdgcn_exp2f((m_reg - mn) * C2); m_reg = mn; }
    const float mnL = rowmask ? -__builtin_inff() : -mn * C2;
#pragma unroll
    for (int r = 0; r < 16; ++r) p0[r] = fmaf(p0[r], C2, mnL);
#pragma unroll
    for (int r = 0; r < 16; ++r) p1[r] = fmaf(p1[r], C2, mnL);
#pragma unroll
    for (int r = 0; r < 16; ++r) p0[r] = __builtin_amdgcn_exp2f(p0[r]);
}
__device__ __forceinline__ void finishSM(f32x16& p0, f32x16& p1, float alpha, float& l_reg, bf16x8& pa0, bf16x8& pa1, bf16x8& pa2, bf16x8& pa3) {
#pragma unroll
    for (int r = 0; r < 16; ++r) p1[r] = __builtin_amdgcn_exp2f(p1[r]);
    float ps = 0;
#pragma unroll
    for (int r = 0; r < 16; ++r) ps += p0[r];
#pragma unroll
    for (int r = 0; r < 16; ++r) ps += p1[r];
    { auto rr = __builtin_amdgcn_permlane32_swap(__float_as_uint(ps), __float_as_uint(ps), false, false);
      ps = __uint_as_float(rr[0]) + __uint_as_float(rr[1]); }
    l_reg = l_reg * alpha + ps;
#define PK4(P, B_, OUT) do { unsigned a0 = cvt_pk_bf16(P[B_+0], P[B_+1]), a1 = cvt_pk_bf16(P[B_+2], P[B_+3]);                          \
        unsigned b0 = cvt_pk_bf16(P[B_+4], P[B_+5]), b1 = cvt_pk_bf16(P[B_+6], P[B_+7]);                                             \
        auto r0 = __builtin_amdgcn_permlane32_swap(a0, b0, false, false); auto r1 = __builtin_amdgcn_permlane32_swap(a1, b1, false, false); \
        u32x4 w = {r0[0], r1[0], r0[1], r1[1]}; OUT = *reinterpret_cast<bf16x8*>(&w); } while (0)
    PK4(p0, 0, pa0); PK4(p0, 8, pa1); PK4(p1, 0, pa2); PK4(p1, 8, pa3);
#undef PK4
}
template <int KB>
__device__ __forceinline__ void qkt(f32x16& p0, f32x16& p1, const char* K_lds, int r32, int hi, const bf16x8* qr) {
    p0 = f32x16{}; p1 = f32x16{};
    const char* kb[4];
#pragma unroll
    for (int dd = 0; dd < 4; ++dd) kb[dd] = K_lds + KB * SHM_K + KSWZ(r32, (dd * 16 + hi * 8) * 2);
#pragma unroll
    for (int d0 = 0; d0 < 8; ++d0) { const char* a = kb[d0 & 3] + (d0 >> 2) * 128;
        bf16x8 b0 = *reinterpret_cast<const bf16x8*>(a);
        bf16x8 b1 = *reinterpret_cast<const bf16x8*>(a + 32 * 256);
        p0 = __builtin_amdgcn_mfma_f32_32x32x16_bf16(b0, qr[d0], p0, 0, 0, 0);
        p1 = __builtin_amdgcn_mfma_f32_32x32x16_bf16(b1, qr[d0], p1, 0, 0, 0); }
}
template <int VB>
__device__ __forceinline__ void pv_tile(f32x16* o, int vb0, bf16x8 pa0, bf16x8 pa1, bf16x8 pa2, bf16x8 pa3) {
#define TRRD(dst, off) asm volatile("ds_read_b64_tr_b16 %0, %1 offset:%2" : "=&v"(dst) : "v"(vb0), "i"(off) : "memory")
#define PV_RD(S_, d0) do { constexpr int b_ = VB * SHM_V + v_rd_off(d0, 0, 0); \
        TRRD(S_##l0, b_); TRRD(S_##h0, b_ + 2048); TRRD(S_##l1, b_ + 4096); TRRD(S_##h1, b_ + 6144); TRRD(S_##l2, b_ + 8192); TRRD(S_##h2, b_ + 10240); TRRD(S_##l3, b_ + 12288); TRRD(S_##h3, b_ + 14336); } while (0)
#define PV_MM(S_, d0) do { \
        o[d0] = __builtin_amdgcn_mfma_f32_32x32x16_bf16(pa0, (bf16x8){S_##l0[0], S_##l0[1], S_##l0[2], S_##l0[3], S_##h0[0], S_##h0[1], S_##h0[2], S_##h0[3]}, o[d0], 0, 0, 0);   \
        o[d0] = __builtin_amdgcn_mfma_f32_32x32x16_bf16(pa1, (bf16x8){S_##l1[0], S_##l1[1], S_##l1[2], S_##l1[3], S_##h1[0], S_##h1[1], S_##h1[2], S_##h1[3]}, o[d0], 0, 0, 0);   \
        o[d0] = __builtin_amdgcn_mfma_f32_32x32x16_bf16(pa2, (bf16x8){S_##l2[0], S_##l2[1], S_##l2[2], S_##l2[3], S_##h2[0], S_##h2[1], S_##h2[2], S_##h2[3]}, o[d0], 0, 0, 0);   \
        o[d0] = __builtin_amdgcn_mfma_f32_32x32x16_bf16(pa3, (bf16x8){S_##l3[0], S_##l3[1], S_##l3[2], S_##l3[3], S_##h3[0], S_##h3[1], S_##h3[2], S_##h3[3]}, o[d0], 0, 0, 0); } while (0)
    s16x4 Al0, Al1, Al2, Al3, Ah0, Ah1, Ah2, Ah3, Bl0, Bl1, Bl2, Bl3, Bh0, Bh1, Bh2, Bh3;
    PV_RD(A, 0);
    asm volatile("s_waitcnt lgkmcnt(0)" ::: "memory"); SBAR(); PV_RD(B, 1); SBAR(); PV_MM(A, 0); SBAR();
    asm volatile("s_waitcnt lgkmcnt(0)" ::: "memory"); SBAR(); PV_RD(A, 2); SBAR(); PV_MM(B, 1); SBAR();
    asm volatile("s_waitcnt lgkmcnt(0)" ::: "memory"); SBAR(); PV_RD(B, 3); SBAR(); PV_MM(A, 2); SBAR();
    asm volatile("s_waitcnt lgkmcnt(0)" ::: "memory"); SBAR(); PV_MM(B, 3);
#undef PV_MM
#undef PV_RD
#undef TRRD
}
template <int VB>
__device__ __forceinline__ void pv_partial(f32x16* o, int vb0, bf16x8 pa0, bf16x8 pa1, bf16x8 pa2, bf16x8 pa3, f32x16& p0, f32x16& p1, float& m_reg, float& mn, float& alpha, const bool rowmask) {
#define TRRD(dst, off) asm volatile("ds_read_b64_tr_b16 %0, %1 offset:%2" : "=&v"(dst) : "v"(vb0), "i"(off) : "memory")
#define PV_RD(S_, d0) do { constexpr int b_ = VB * SHM_V + v_rd_off(d0, 0, 0); \
        TRRD(S_##l0, b_); TRRD(S_##h0, b_ + 2048); TRRD(S_##l1, b_ + 4096); TRRD(S_##h1, b_ + 6144); TRRD(S_##l2, b_ + 8192); TRRD(S_##h2, b_ + 10240); TRRD(S_##l3, b_ + 12288); TRRD(S_##h3, b_ + 14336); } while (0)
#define PV_MM(S_, d0) do { \
        o[d0] = __builtin_amdgcn_mfma_f32_32x32x16_bf16(pa0, (bf16x8){S_##l0[0], S_##l0[1], S_##l0[2], S_##l0[3], S_##h0[0], S_##h0[1], S_##h0[2], S_##h0[3]}, o[d0], 0, 0, 0);   \
        o[d0] = __builtin_amdgcn_mfma_f32_32x32x16_bf16(pa1, (bf16x8){S_##l1[0], S_##l1[1], S_##l1[2], S_##l1[3], S_##h1[0], S_##h1[1], S_##h1[2], S_##h1[3]}, o[d0], 0, 0, 0);   \
        o[d0] = __builtin_amdgcn_mfma_f32_32x32x16_bf16(pa2, (bf16x8){S_##l2[0], S_##l2[1], S_##l2[2], S_##l2[3], S_##h2[0], S_##h2[1], S_##h2[2], S_##h2[3]}, o[d0], 0, 0, 0);   \
        o[d0] = __builtin_amdgcn_mfma_f32_32x32x16_bf16(pa3, (bf16x8){S_##l3[0], S_##l3[1], S_##l3[2], S_##l3[3], S_##h3[0], S_##h3[1], S_##h3[2], S_##h3[3]}, o[d0], 0, 0, 0); } while (0)
    s16x4 Al0, Al1, Al2, Al3, Ah0, Ah1, Ah2, Ah3, Bl0, Bl1, Bl2, Bl3, Bh0, Bh1, Bh2, Bh3;
    constexpr float C2 = 1.4426950408889634f * SCALE;
    PV_RD(A, 0);
    asm volatile("s_waitcnt lgkmcnt(0)" ::: "memory"); SBAR(); PV_RD(B, 1); SBAR();
    PV_MM(A, 0);
    float pmax = p0[0];
#pragma unroll
    for (int r = 1; r < 16; ++r) pmax = fmaxf(pmax, p0[r]);
#pragma unroll
    for (int r = 0; r < 16; ++r) pmax = fmaxf(pmax, p1[r]);
    SBAR();
    asm volatile("s_waitcnt lgkmcnt(0)" ::: "memory"); SBAR(); PV_RD(A, 2); SBAR();
    PV_MM(B, 1);
    { auto rr = __builtin_amdgcn_permlane32_swap(__float_as_uint(pmax), __float_as_uint(pmax), false, false);
      pmax = fmaxf(__uint_as_float(rr[0]), __uint_as_float(rr[1])); }
    pmax = rowmask ? -__builtin_inff() : pmax;
    if (__builtin_expect(__all((pmax - m_reg) * SCALE <= THR), 1)) { mn = m_reg; alpha = 1.f; }
    else { mn = fmaxf(m_reg, pmax); alpha = __builtin_amdgcn_exp2f((m_reg - mn) * C2); m_reg = mn; }
    const float mnL = rowmask ? -__builtin_inff() : -mn * C2;
    SBAR();
    asm volatile("s_waitcnt lgkmcnt(0)" ::: "memory"); SBAR(); PV_RD(B, 3); SBAR();
    PV_MM(A, 2);
#pragma unroll
    for (int r = 0; r < 16; ++r) p0[r] = fmaf(p0[r], C2, mnL);
#pragma unroll
    for (int r = 0; r < 16; ++r) p1[r] = fmaf(p1[r], C2, mnL);
    asm volatile("" : "+v"(p0), "+v"(p1));
    SBAR();
    asm volatile("s_waitcnt lgkmcnt(0)" ::: "memory"); SBAR();
    PV_MM(B, 3);
#pragma unroll
    for (int r = 0; r < 16; ++r) p0[r] = __builtin_amdgcn_exp2f(p0[r]);
    asm volatile("" : "+v"(p0));
#undef PV_MM
#undef PV_RD
#undef TRRD
}
struct BlockRef { int bh, qb; };
struct Seam { bf16x8 qr[8]; bf16x8 st_v0, st_v1, st_k0, st_k1; };
__device__ __forceinline__ const char* q_rows(const unsigned char* ws, const BlockRef& r) { return (const char*)(ws + WS_Q) + ((size_t)r.bh * SEQ + (size_t)r.qb * QB) * (D * 2); }
__device__ __forceinline__ const char* k_head(const unsigned char* ws, const BlockRef& r) { return (const char*)(ws + WS_K) + (size_t)r.bh * SEQ * (D * 2); }
__device__ __forceinline__ const char* v_head(const unsigned char* ws, const BlockRef& r) { return (const char*)(ws + WS_V) + (size_t)r.bh * SEQ * (D * 2); }
__device__ __forceinline__ bf16x8 ld16(const char* sbase, unsigned voff) { return *reinterpret_cast<const bf16x8*>(sbase + voff); }
#define VMW() asm volatile("s_waitcnt vmcnt(0)" ::: "memory")
#define VMWN(n) asm volatile("s_waitcnt vmcnt(%0)" :: "i"(n) : "memory")
#define SLOAD_H(Kp, Vp, k0) do { const char* vt_ = (Vp) + (size_t)(k0) * (D * 2); const char* kt_ = (Kp) + (size_t)(k0) * (D * 2); \
                         S.st_v0 = ld16(vt_, lo0); S.st_v1 = ld16(vt_, lo1); S.st_k0 = ld16(kt_, lo0); S.st_k1 = ld16(kt_, lo1); } while (0)
#define SWRITE_HK(bf) do { *(bf16x8*)(K_lds + (bf) * SHM_K + kws) = S.st_k0; *(bf16x8*)(K_lds + (bf) * SHM_K + kws + 32 * 256) = S.st_k1; } while (0)
#define SWRITE_HV(bf) do { *(bf16x8*)(V_lds + (bf) * SHM_V + vst0) = S.st_v0; *(bf16x8*)(V_lds + (bf) * SHM_V + vst1) = S.st_v1; } while (0)
#define SWRITE_H(bf) do { SWRITE_HV(bf); SWRITE_HK(bf); } while (0)
#define QLOAD(r_) do { const char* qb_ = q_rows(ws, (r_)); _Pragma("unroll") for (int d0 = 0; d0 < 8; ++d0) S.qr[d0] = ld16(qb_, qoff + d0 * 32); } while (0)
__device__ __forceinline__ void moba_prime(const unsigned char* ws, const BlockRef& cur, char* lds, Seam& S, const int wid) {
    const int lane = lane_id(), tid = wid * 64 + lane, r32 = lane & 31, hi = lane >> 5;
    const int sr = tid >> 4, sc = (tid & 15) * 8, kws = KSWZ(sr, sc * 2); char* K_lds = lds + 2 * SHM_V;
    const unsigned lo0 = (unsigned)(sr * D + sc) * 2u, lo1 = lo0 + 32u * D * 2u, qoff = (unsigned)((wid * QBLK + r32) * D + hi * 8) * 2u;
    *(u32x4*)(lds + OFF_KM + tid * 16) = (u32x4){0u, 0u, 0u, 0u};
    QLOAD(cur);
    SLOAD_H(k_head(ws, cur), v_head(ws, cur), 0); VMW(); SWRITE_HK(0);
    __syncthreads();
}
__device__ __forceinline__ void moba_block(const unsigned char* ws_, const BlockRef& cur, const BlockRef& nxt, char* lds, Seam& S, const int wid) {
    unsigned long long wsi = (unsigned long long)ws_; asm volatile("" : "+s"(wsi));
    const unsigned char* ws = (const unsigned char*)(const GAS unsigned char*)wsi;
    const int lane = lane_id(), tid = wid * 64 + lane, r32 = lane & 31, hi = lane >> 5;
    const int qb = cur.qb, NT = 4 * (qb + 1);
    const int qlo = wid * QBLK, qm = qlo + r32 - 4 * hi;
    char* V_lds = lds; char* K_lds = lds + 2 * SHM_V;
    float* wsf = (float*)(lds + OFF_WS) + wid * 64; float* li_l = wsf, * al_l = wsf + 32;
    float m_reg = -1e30f, l_reg = 0; f32x16 o[4] = {};
    const int sr = tid >> 4, sc = (tid & 15) * 8, vst0 = v_st(sr, sc), vst1 = v_st(32 + sr, sc), kws = KSWZ(sr, sc * 2);
    const unsigned lo0 = (unsigned)(sr * D + sc) * 2u, lo1 = lo0 + 32u * D * 2u, qoff = (unsigned)((wid * QBLK + r32) * D + hi * 8) * 2u;
    const int vb0 = (int)(uintptr_t)V_lds + v_rd_base(lane);
    const char* Kh = k_head(ws, cur); const char* Vh = v_head(ws, cur);
    unsigned sel = 0u;
    if (qb > 0) {
        if (tid < 256) { const int row = tid >> 4, ch = tid & 15; *(bf16x8*)(lds + OFF_KM + KSWZ(row, ch * 16)) = ld16((const char*)(ws + WS_KMEAN) + (size_t)cur.bh * NBLK * (D * 2), (unsigned)(row * D + ch * 8) * 2u); }
        __syncthreads();
        f32x16 g = f32x16{};
        { const char* kmb[4];
#pragma unroll
          for (int dd = 0; dd < 4; ++dd) kmb[dd] = lds + OFF_KM + KSWZ(r32, (dd * 16 + hi * 8) * 2);
#pragma unroll
          for (int d0 = 0; d0 < 8; ++d0) { const bf16x8 b0 = *reinterpret_cast<const bf16x8*>(kmb[d0 & 3] + (d0 >> 2) * 128); g = __builtin_amdgcn_mfma_f32_32x32x16_bf16(b0, S.qr[d0], g, 0, 0, 0); } }
        float gv[16];
#pragma unroll
        for (int r = 0; r < 8; ++r) { const float mine = g[r], oth = __shfl_xor(mine, 32); const int kb_ = (r & 3) + 8 * (r >> 2);
            gv[kb_] = hi ? oth : mine; gv[kb_ + 4] = hi ? mine : oth; }
        const float NEGI = -__builtin_inff();
#pragma unroll
        for (int n = 0; n < 16; ++n) if (n >= qb) gv[n] = NEGI;
#pragma unroll
        for (int k = 0; k < 3; ++k) { float best = NEGI; int bi = -1;
#pragma unroll
            for (int n = 0; n < 16; ++n) { const bool ok = (((sel >> n) & 1u) == 0u) && (gv[n] > best); best = ok ? gv[n] : best; bi = ok ? n : bi; }
            if (bi >= 0) sel |= 1u << bi; }
    }
#define RESC(a) do { if (__any((a) < 1.f)) { if (hi == 0) al_l[r32] = (a); asm volatile("s_waitcnt lgkmcnt(0)" ::: "memory");              \
                     _Pragma("unroll") for (int d_ = 0; d_ < 4; ++d_) _Pragma("unroll") for (int r = 0; r < 16; ++r) o[d_][r] *= al_l[crow(r, hi)]; } } while (0)
#define KBASE(t) ((t) * KVBLK)
#define MASKT(P0_, P1_, t, RM_) do { const int jb_ = (t) >> 2; RM_ = (jb_ != qb) && (((sel >> jb_) & 1u) == 0u);                                          \
                                if (jb_ == qb) { const int kb_ = ((t) & 3) * KVBLK; if (kb_ + KVBLK - 1 > qlo) mask_tile(P0_, P1_, qm - kb_); } } while (0)
    constexpr int NQL = 8;
#define SEAM_K0() do { VMWN(NQL); SWRITE_HK(0); SBAR(); } while (0)
    f32x16 pA0, pA1, pB0, pB1; float mnA, mnB, alA, alB; bf16x8 pa0, pa1, pa2, pa3;
    SWRITE_HV(0); SBAR();
    if (NT > 1) { SLOAD_H(Kh, Vh, KBASE(1)); }
    SBAR(); qkt<0>(pA0, pA1, K_lds, r32, hi, S.qr);
    { bool rm_; MASKT(pA0, pA1, 0, rm_); partialSM(pA0, pA1, m_reg, mnA, alA, rm_); }
    if (NT > 1) { VMW(); SWRITE_H(1); }
    __syncthreads();
#define HALF_STEP(PX0, PX1, mnX, alX, PY0, PY1, alY, t, KB, VB, SB) do {                                                      \
        SBAR(); if ((t) + 1 < NT) { SLOAD_H(Kh, Vh, KBASE((t) + 1)); SBAR(); }                                               \
        qkt<KB>(PX0, PX1, K_lds, r32, hi, S.qr);                                             \
        finishSM(PY0, PY1, alY, l_reg, pa0, pa1, pa2, pa3); SBAR();                                                           \
        { bool rm_; MASKT(PX0, PX1, (t), rm_); pv_partial<VB>(o, vb0, pa0, pa1, pa2, pa3, PX0, PX1, m_reg, mnX, alX, rm_); }                                                               \
        __syncthreads();                                                                                                      \
        if ((t) + 1 < NT) { VMW(); SWRITE_H(SB); }                                                                          \
        RESC(alX); __syncthreads(); } while (0)
    for (int t = 1; t + 1 < NT; t += 2) {
        HALF_STEP(pB0, pB1, mnB, alB, pA0, pA1, alA, t, 1, 0, 0);
        HALF_STEP(pA0, pA1, mnA, alA, pB0, pB1, alB, t + 1, 0, 1, 1);
    }
    const bool even = (NT & 1) == 0;
    if (even) { SBAR(); qkt<1>(pB0, pB1, K_lds, r32, hi, S.qr); SBAR(); }
    SLOAD_H(k_head(ws, nxt), v_head(ws, nxt), 0); SBAR();
    QLOAD(nxt);
    SBAR();
    finishSM(pA0, pA1, alA, l_reg, pa0, pa1, pa2, pa3); SBAR();
    pv_tile<0>(o, vb0, pa0, pa1, pa2, pa3);
    if (even) { { bool rm_; MASKT(pB0, pB1, NT - 1, rm_); partialSM(pB0, pB1, m_reg, mnB, alB, rm_); } __syncthreads(); RESC(alB);
        finishSM(pB0, pB1, alB, l_reg, pa0, pa1, pa2, pa3); SBAR(); pv_tile<1>(o, vb0, pa0, pa1, pa2, pa3); }
    SBAR(); SEAM_K0();
    if (hi == 0) li_l[r32] = l_reg; asm volatile("s_waitcnt lgkmcnt(0)" ::: "memory");
    float rli[16];
#pragma unroll
    for (int r = 0; r < 16; ++r) rli[r] = __builtin_amdgcn_rcpf(li_l[crow(r, hi)]);
    { const int b = cur.bh / NH, h = cur.bh % NH;
      int r32e = r32, hie = hi; asm volatile("" : "+v"(r32e), "+v"(hie));
      const float so = ((const float*)(ws + WS_SCL))[NE + 2];
      char* Ob = (char*)(ws + WS_O) + (((size_t)b * SEQ + (size_t)qb * QB + (size_t)(wid * QBLK)) * LDO + (size_t)h * D);
      const unsigned obase = (unsigned)(4 * hie * LDO + r32e);
#pragma unroll
      for (int r = 0; r < 16; ++r) { const unsigned ooff = obase + (unsigned)(((r & 3) + 8 * (r >> 2)) * LDO); const float sc_ = rli[r] * so;
#pragma unroll
        for (int d0 = 0; d0 < 4; ++d0) { const float v = o[d0][r] * sc_;
            const float v1 = quad_xor1(v), v2 = quad_xor2(v), v3 = quad_xor2(v1);
            int pk = __builtin_amdgcn_cvt_pk_fp8_f32(v, v1, 0, false); pk = __builtin_amdgcn_cvt_pk_fp8_f32(v2, v3, pk, true);
            if ((r32e & 3) == 0) *(unsigned*)(Ob + ooff + d0 * 32) = (unsigned)pk; } } }
    __syncthreads();
#undef RESC
#undef KBASE
#undef MASKT
#undef SEAM_K0
#undef HALF_STEP
}
#undef VMW
#undef VMWN
#undef SLOAD_H
#undef SWRITE_HK
#undef SWRITE_HV
#undef SWRITE_H
#undef QLOAD
__device__ __forceinline__ BlockRef block_ref(int item, int pass) { BlockRef r; r.bh = item >> 3; const int y = item & 7; r.qb = pass ? (NBLK - 1 - y) : y; return r; }
template <class Side> __device__ __forceinline__ void attn_phase(char* lds, const unsigned char* ws, int G, int vcu, const int wid, const Side& side) {
    constexpr int NITEMS = NB * NH * (NBLK / 2);
    const int ipc = (NITEMS + G - 1) / G, first = vcu * ipc; int last = first + ipc; if (last > NITEMS) last = NITEMS;
    if (first >= last) { side(0, 1); return; }
    const int nblk = 2 * (last - first);
    side(0, nblk + 1);
    BlockRef cur = block_ref(first, 0);
    Seam S;
    moba_prime(ws, cur, lds, S, wid);
    for (int k = 0; k < nblk; ++k) {
        const int kn = (k + 1 < nblk) ? k + 1 : k;
        const BlockRef nxt = block_ref(first + (kn >> 1), kn & 1);
        moba_block(ws, cur, nxt, lds, S, wid);
        side(k + 1, nblk + 1);
        cur = nxt;
    }
}
#undef KSWZ
#undef SBAR
}

struct Frame {
    LAS unsigned char* lds;
    volatile LAS unsigned* MISC;
    unsigned* ctl;
    int wave, vcu, G;
    unsigned char* ws;
    __device__ __forceinline__ const float* in(int k) const { const volatile LAS unsigned* p = MISC + 64 + 2 * k; const unsigned lo = __builtin_amdgcn_readfirstlane((int)p[0]), hi = __builtin_amdgcn_readfirstlane((int)p[1]);
        return (const float*)(const GAS float*)(((unsigned long long)hi << 32) | lo); }
    float* out;
};
enum { I_X = 0, I_POOLW, I_POOLS, I_WKV, I_WQ, I_WO, I_FG, I_FU, I_FD, I_MR, I_MG, I_MU, I_MD, I_LMG, I_LMB, I_LFG, I_LFB };

template <int MODE> __device__ __forceinline__ int rowmap(int n) {
    if (MODE == 0) return n;
    if (MODE == 1) return (n >> 7) * 256 + (n & 127);
    if (MODE == 2) return (n >> 7) * 256 + 128 + (n & 127);
    const int h = n >> 7, d = n & 127;
    return (h >> 1) * 256 + (d >> 6) * 128 + (h & 1) * 64 + (d & 63);
}
template <int MODE> __device__ __forceinline__ void transpose_item(const float* W, int K, int N, int ldw, bf16_t* WT, LAS float* scr, int item, int lane) {
    const int nblk = N / 32, kb = item / nblk, nb = item % nblk, k0 = 64 * kb, n0 = 32 * nb;
#pragma unroll 8
    for (int i = 0; i < 32; ++i) { const int kk = 2 * i + (lane >> 5); scr[kk * 33 + (lane & 31)] = W[(size_t)(k0 + kk) * ldw + n0 + (lane & 31)]; }
    LDS_WAIT(); asm volatile("" ::: "memory");
    const int c = lane & 7;
#pragma unroll
    for (int j = 0; j < 4; ++j) { const int n = (lane >> 3) + 8 * j; const LAS float* s = scr + (8 * c) * 33 + n;
        u32x4 o; o.x = cvt_pk_bf16(s[0 * 33], s[1 * 33]); o.y = cvt_pk_bf16(s[2 * 33], s[3 * 33]); o.z = cvt_pk_bf16(s[4 * 33], s[5 * 33]); o.w = cvt_pk_bf16(s[6 * 33], s[7 * 33]);
        *(u32x4*)(WT + (size_t)rowmap<MODE>(n0 + n) * K + k0 + 8 * c) = o; }
    LDS_WAIT(); asm volatile("" ::: "memory");
}
__device__ __forceinline__ void convert_family(Frame& F, const float* W, int K, int N, size_t src_stride, bf16_t* WT, size_t dst_stride, int nmat) {
    const int lane_ = lane_id(), tid_ = F.wave * 64 + lane_; (void)tid_;
    constexpr int PITCH = 528;
    LAS unsigned char* tile = F.lds + RING_OFF;
    const int KT = K / 256, NT_ = N / 64, per = KT * NT_, total = per * nmat;
    const int cg = lane_ & 15, slot = F.wave * 4 + (lane_ >> 4);
    for (int it = F.vcu; it < total; it += F.G) { const int mi = it / per, r = it - mi * per, kt = r / NT_, nt = r - kt * NT_;
        const float* src = W + (size_t)mi * src_stride + ((size_t)kt * 256 + slot * 8) * N + nt * 64 + 4 * cg;
        f32x4 v[8];
#pragma unroll
        for (int i = 0; i < 8; ++i) v[i] = *(const f32x4*)(src + (size_t)i * N);
#pragma unroll
        for (int c = 0; c < 4; ++c) { u32x4 o; o.x = cvt_pk_bf16(v[0][c], v[1][c]); o.y = cvt_pk_bf16(v[2][c], v[3][c]); o.z = cvt_pk_bf16(v[4][c], v[5][c]); o.w = cvt_pk_bf16(v[6][c], v[7][c]);
            *(LAS u32x4*)(tile + (4 * cg + c) * PITCH + slot * 16) = o; }
        __syncthreads();
        bf16_t* dst = WT + (size_t)mi * dst_stride;
#pragma unroll
        for (int p = 0; p < 4; ++p) { const int n = p * 16 + (tid_ >> 5), kb = (tid_ & 31) * 16;
            *(u32x4*)((unsigned char*)(dst + (size_t)(nt * 64 + n) * K + kt * 256) + kb) = *(const LAS u32x4*)(tile + n * PITCH + kb); }
        __syncthreads(); }
}
__device__ __forceinline__ int rowmap_rt(int mode, int n) { return mode == 0 ? rowmap<0>(n) : mode == 1 ? rowmap<1>(n) : mode == 2 ? rowmap<2>(n) : rowmap<3>(n); }
struct StripDesc { const float* W; int ldw, n0, mode; i8_t* WT; float* SW; };
constexpr int NS_M = NE * 2 * (DFE / 32), NS_F = 2 * (DFF / 32), NS_Q = 3 * (DM / 32);
__device__ __forceinline__ void strip_load(f32x4 (&v)[32], const StripDesc& d, int cg, int slot) {
    const float* src = d.W + (size_t)(slot * 32) * d.ldw + d.n0 + 4 * cg;
#pragma unroll
    for (int i = 0; i < 32; ++i) v[i] = __builtin_nontemporal_load((const f32x4*)(src + (size_t)i * d.ldw));
}
template <class Item> __device__ __forceinline__ void quant_strips(Frame& F, LAS unsigned char* tile, int j0, int j1, const Item& item) {
    const int lane_ = lane_id(), tid_ = F.wave * 64 + lane_;
    LAS float* red = (LAS float*)(tile + 32 * 2064);
    const int cg = lane_ & 7, slot = F.wave * 8 + (lane_ >> 3);
    f32x4 v[32]; StripDesc cur, nx;
    bool have = (j0 < j1) && item(j0, cur);
    if (have) strip_load(v, cur, cg, slot);
    for (int j = j0; have; ++j) {
        f32x4 mx = (f32x4){0.f, 0.f, 0.f, 0.f};
#pragma unroll
        for (int i = 0; i < 32; ++i) mx = __builtin_elementwise_max(mx, __builtin_elementwise_abs(v[i]));
#pragma unroll
        for (int c = 0; c < 4; ++c) { float t = mx[c]; t = fmaxf(t, __shfl_xor(t, 8)); t = fmaxf(t, __shfl_xor(t, 16)); t = fmaxf(t, __shfl_xor(t, 32)); mx[c] = t; }
        if ((lane_ >> 3) == 0) *(LAS f32x4*)(red + F.wave * 32 + 4 * cg) = mx;
        __syncthreads();
        f32x4 cm = *(const LAS f32x4*)(red + 4 * cg);
#pragma unroll
        for (int w = 1; w < 8; ++w) cm = __builtin_elementwise_max(cm, *(const LAS f32x4*)(red + w * 32 + 4 * cg));
        f32x4 inv, sc;
#pragma unroll
        for (int c = 0; c < 4; ++c) { sc[c] = cm[c] > 0.f ? cm[c] * (1.f / 127.f) : 1.f; inv[c] = cm[c] > 0.f ? 127.f / cm[c] : 0.f; }
        const bool hn = (j + 1 < j1) && item(j + 1, nx);
        const float* nsrc = hn ? nx.W + (size_t)(slot * 32) * nx.ldw + nx.n0 + 4 * cg : nullptr; const size_t nld = hn ? (size_t)nx.ldw : 0;
#pragma unroll
        for (int p8 = 0; p8 < 4; ++p8) {
#pragma unroll
            for (int c = 0; c < 4; ++c) { u32x2 d;
                d.x = pack_i8x4(v[8 * p8][c] * inv[c], v[8 * p8 + 1][c] * inv[c], v[8 * p8 + 2][c] * inv[c], v[8 * p8 + 3][c] * inv[c]);
                d.y = pack_i8x4(v[8 * p8 + 4][c] * inv[c], v[8 * p8 + 5][c] * inv[c], v[8 * p8 + 6][c] * inv[c], v[8 * p8 + 7][c] * inv[c]);
                *(LAS u32x2*)(tile + (4 * cg + c) * 2064 + slot * 32 + 8 * p8) = d; }
            asm volatile("" ::: "memory");
            if (hn) {
#pragma unroll
                for (int i = 8 * p8; i < 8 * p8 + 8; ++i) v[i] = __builtin_nontemporal_load((const f32x4*)(nsrc + (size_t)i * nld)); }
            asm volatile("" ::: "memory");
        }
        if (slot == 0) {
#pragma unroll
            for (int c = 0; c < 4; ++c) cur.SW[rowmap_rt(cur.mode, cur.n0 + 4 * cg + c)] = sc[c]; }
        __syncthreads();
#pragma unroll
        for (int it = 0; it < 8; ++it) { const int n = it * 4 + (tid_ >> 7), kb = (tid_ & 127) * 16;
            __builtin_nontemporal_store(*(const LAS u32x4*)(tile + n * 2064 + kb), (u32x4*)(cur.WT + (size_t)rowmap_rt(cur.mode, cur.n0 + n) * 2048 + kb)); }
        __syncthreads();
        cur = nx; have = hn;
    }
}
struct MoeStripItem { Frame& F;
    __device__ __forceinline__ bool operator()(int j, StripDesc& d) const { const int st = F.vcu + F.G * j; if (st >= NS_M) return false;
        const int e = st / (2 * (DFE / 32)), r = st % (2 * (DFE / 32)), up = r >= DFE / 32 ? 1 : 0;
        d.W = (up ? F.in(I_MU) : F.in(I_MG)) + (size_t)e * DM * DFE; d.ldw = DFE; d.n0 = 32 * (r - up * (DFE / 32)); d.mode = 1 + up;
        d.WT = (i8_t*)(F.ws + WS_MWGU) + (size_t)e * 2 * DFE * DM; d.SW = (float*)(F.ws + WS_SWM) + (size_t)e * 2 * DFE; return true; } };
struct DenseStripItem { Frame& F;
    __device__ __forceinline__ bool operator()(int j, StripDesc& d) const { const int st = F.vcu + F.G * j; if (st >= NS_F + NS_Q) return false;
        if (st < NS_F) { const int up = st >= DFF / 32 ? 1 : 0; d.W = up ? F.in(I_FU) : F.in(I_FG); d.ldw = DFF; d.n0 = 32 * (st - up * (DFF / 32)); d.mode = 1 + up;
            d.WT = (i8_t*)(F.ws + WS_WGU); d.SW = (float*)(F.ws + WS_SWGU); }
        else { const int r = st - NS_F, which = r / (DM / 32); d.W = which == 0 ? F.in(I_WQ) : (which == 1 ? F.in(I_WKV) : F.in(I_WKV) + DM); d.ldw = which == 0 ? DM : 2 * DM;
            d.n0 = 32 * (r % (DM / 32)); d.mode = which == 2 ? 0 : 3; d.WT = (i8_t*)(F.ws + WS_WQKV) + (size_t)which * DM * DM; d.SW = (float*)(F.ws + WS_SWQKV) + which * DM; }
        return true; } };
__device__ __forceinline__ void quant_weights(Frame& F) { quant_strips(F, F.lds + RING_OFF, 0, (NS_F + NS_Q + F.G - 1) / F.G, DenseStripItem{F}); }
__device__ __forceinline__ void down_scale_sample(Frame& F) {
    const int lane_ = lane_id(), tid_ = F.wave * 64 + lane_;
    LAS float* red = (LAS float*)(F.lds + RING_OFF);
    if (F.vcu < NE + 2) { const int w = F.vcu; const int K = w < NE ? DFE : (w == NE ? DFF : DM); const float* W = w < NE ? F.in(I_MD) + (size_t)w * DFE * DM : (w == NE ? F.in(I_FD) : F.in(I_WO));
        f32x4 mx = (f32x4){0.f, 0.f, 0.f, 0.f};
#pragma unroll 8
        for (int i = 0; i < 32; ++i) mx = __builtin_elementwise_max(mx, __builtin_elementwise_abs(*(const f32x4*)(W + (size_t)i * (K / 32) * DM + 4 * tid_)));
        const float m = wave_max(fmaxf(fmaxf(mx[0], mx[1]), fmaxf(mx[2], mx[3])));
        if (lane_ == 0) red[F.wave] = m;
        __syncthreads();
        if (tid_ == 0) { float t = red[0]; for (int i = 1; i < NWAVES; ++i) t = fmaxf(t, red[i]);
            const unsigned eb = (__float_as_uint(t) >> 23) & 0xffu;
            ((float*)(F.ws + WS_SCL))[w] = (eb < 5u || eb > 250u) ? 1.0f : __uint_as_float((258u - eb) << 23); }
        __syncthreads();
    }
}
__device__ __forceinline__ void down_quant(Frame& F, LAS unsigned char* tile, const float* W, int K, int nmat, const float* scl, unsigned char* WT, int j0, int j1) {
    const int lane_ = lane_id(), tid_ = F.wave * 64 + lane_;
    constexpr int NT_ = DM / 64, TK = 512, RPT = TK / 32, PITCH = TK + 16;
    const int KT = K / TK, PER = KT * NT_, TOTAL = PER * nmat;
    const int cg = lane_ & 15, slot = F.wave * 4 + (lane_ >> 4);
    f32x4 v[RPT], nv[RPT];
    bool have = j0 < j1 && F.vcu + F.G * j0 < TOTAL;
    if (have) { const int it = F.vcu + F.G * j0, e = it / PER, r = it % PER, kt = r / NT_, nt = r % NT_; const float* src = W + ((size_t)e * K + (size_t)kt * TK + slot * RPT) * DM + nt * 64 + 4 * cg;
#pragma unroll
        for (int i = 0; i < RPT; ++i) nv[i] = __builtin_nontemporal_load((const f32x4*)(src + (size_t)i * DM)); }
    for (int j = j0; have; ++j) { const int it = F.vcu + F.G * j;
        const int e = it / PER, r = it % PER, kt = r / NT_, nt = r % NT_;
#pragma unroll
        for (int i = 0; i < RPT; ++i) v[i] = nv[i];
        const int itn = it + F.G; const bool hn = (j + 1 < j1) && itn < TOTAL;
        if (hn) { const int e2 = itn / PER, r2 = itn % PER, kt2 = r2 / NT_, nt2 = r2 % NT_; const float* src = W + ((size_t)e2 * K + (size_t)kt2 * TK + slot * RPT) * DM + nt2 * 64 + 4 * cg;
#pragma unroll
            for (int i = 0; i < RPT; ++i) nv[i] = __builtin_nontemporal_load((const f32x4*)(src + (size_t)i * DM)); }
        const float sc_ = __uint_as_float((unsigned)__builtin_amdgcn_readfirstlane((int)__float_as_uint(scl[e])));
#define Q8(x) fminf(fmaxf((x) * sc_, -448.f), 448.f)
#pragma unroll
        for (int c = 0; c < 4; ++c) { u32x4 d;
#pragma unroll
            for (int q = 0; q < 4; ++q) { int p0 = __builtin_amdgcn_cvt_pk_fp8_f32(Q8(v[4 * q][c]), Q8(v[4 * q + 1][c]), 0, false); p0 = __builtin_amdgcn_cvt_pk_fp8_f32(Q8(v[4 * q + 2][c]), Q8(v[4 * q + 3][c]), p0, true); d[q] = (unsigned)p0; }
            *(LAS u32x4*)(tile + (4 * cg + c) * PITCH + slot * RPT) = d; }
#undef Q8
        __syncthreads();
#pragma unroll
        for (int p = 0; p < 4; ++p) { const int n = p * 16 + (tid_ >> 5), kb = (tid_ & 31) * 16;
            __builtin_nontemporal_store(*(const LAS u32x4*)(tile + n * PITCH + kb), (u32x4*)(WT + ((size_t)e * DM + nt * 64 + n) * K + kt * TK + kb)); }
        __syncthreads();
        have = hn;
    }
}
__device__ __forceinline__ void moe_side_work(Frame& F, int slot, int nslots) {
    if (slot != (F.vcu >> 3) % nslots) return;
    LAS unsigned char* tile = F.lds + SIDE_OFF;
    quant_strips(F, tile, 0, (NS_M + F.G - 1) / F.G, MoeStripItem{F});
    down_quant(F, tile, F.in(I_MD), DFE, NE, (const float*)(F.ws + WS_SCL), F.ws + WS_MWD, 0, (NE * (DFE / 512) * (DM / 64) + F.G - 1) / F.G);
}
__device__ __forceinline__ void rope_tables(Frame& F) {
    const int lane_ = lane_id(), tid_ = F.wave * 64 + lane_; (void)tid_;
    float* cs = (float*)(F.ws + WS_COS); float* sn = (float*)(F.ws + WS_SIN);
    const int gt = F.vcu * NTHREADS + tid_, NGT = F.G * NTHREADS;
    for (int e = gt; e < SEQ * 64; e += NGT) { const int pos = e >> 6, i = e & 63;
        const float inv = 1.0f / __builtin_exp2f((float)i * (13.287712379549449f / 64.0f));
        const float angf = (float)pos * inv;
        const double turns = (double)angf * 0.15915494309189535; const double fr = turns - __builtin_floor(turns);
        const float frf = (float)fr;
        cs[e] = __builtin_amdgcn_cosf(frf); sn[e] = __builtin_amdgcn_sinf(frf); }
}
__device__ __forceinline__ void pool_diff(Frame& F) {
    const int lane_ = lane_id(), tid_ = F.wave * 64 + lane_; (void)tid_;
    bf16_t* diff = (bf16_t*)(F.ws + WS_DIFF); const float* x = F.in(I_X);
    const int gw = F.vcu * NWAVES + F.wave, NGW = F.G * NWAVES;
    for (int it = gw; it < (M / 32) * 8; it += NGW) { const int j = it & 7, r0 = (it >> 3) * 32, s0 = r0 & (SEQ - 1), w = 2 << (j >> 1);
        const float* xp = x + (size_t)r0 * DM + 256 * j + 4 * lane_; bf16_t* dp = diff + (size_t)r0 * DM + 256 * j + 4 * lane_;
        f32x4 sum = (f32x4){0.f, 0.f, 0.f, 0.f};
        const int have = (s0 + 1 < w) ? s0 + 1 : w;
        for (int i = 1; i < have; ++i) sum += *(const f32x4*)(xp - (size_t)i * DM);
#pragma unroll 16
        for (int rr = 0; rr < 32; ++rr) { const int s = s0 + rr; const f32x4 x0 = *(const f32x4*)(xp + (size_t)rr * DM); sum += x0;
            const int cnt = (s + 1 < w) ? s + 1 : w; const float ic = 1.0f / (float)cnt; const f32x4 d = sum * ic - x0;
            u32x2 o; o.x = cvt_pk_bf16(d[0], d[1]); o.y = cvt_pk_bf16(d[2], d[3]); *(u32x2*)(dp + (size_t)rr * DM) = o;
            if (s + 1 >= w) sum -= *(const f32x4*)(xp + (size_t)(rr - (w - 1)) * DM); } }
}
__device__ __forceinline__ void ln_inplace(f32x4 (&v)[8], const float* g, const float* b, int lane) {
    float s = 0.f;
#pragma unroll
    for (int j = 0; j < 8; ++j) s += (v[j][0] + v[j][1]) + (v[j][2] + v[j][3]);
    const float mean = wave_sum(s) * (1.f / DM); float s2 = 0.f;
#pragma unroll
    for (int j = 0; j < 8; ++j) { v[j] = v[j] - mean; s2 += (v[j][0] * v[j][0] + v[j][1] * v[j][1]) + (v[j][2] * v[j][2] + v[j][3] * v[j][3]); }
    const float rstd = 1.f / sqrtf(wave_sum(s2) * (1.f / DM) + LN_EPS);
#pragma unroll
    for (int j = 0; j < 8; ++j) { const f32x4 gg = *(const f32x4*)(g + 256 * j + 4 * lane), bb = *(const f32x4*)(b + 256 * j + 4 * lane); v[j] = v[j] * rstd * gg + bb; }
}
__device__ __forceinline__ f32x4 bf16x4_to_f32(const u32x2 w) { f32x4 r; r[0] = __uint_as_float(w.x << 16); r[1] = __uint_as_float(w.x & 0xffff0000u); r[2] = __uint_as_float(w.y << 16); r[3] = __uint_as_float(w.y & 0xffff0000u); return r; }
__device__ __forceinline__ f32x4 ld_bf16x4(const bf16_t* p) { const u32x2 w = *(const u32x2*)p; f32x4 r; r[0] = __uint_as_float(w.x << 16); r[1] = __uint_as_float(w.x & 0xffff0000u); r[2] = __uint_as_float(w.y << 16); r[3] = __uint_as_float(w.y & 0xffff0000u); return r; }
__device__ __forceinline__ void store_row_f32_q(const f32x4 (&v)[8], bf16_t* xf, i8_t* xq, float* sxp, int lane) {
    float am = 0.f;
#pragma unroll
    for (int j = 0; j < 8; ++j) am = fmaxf(fmaxf(am, fmaxf(fabsf(v[j][0]), fabsf(v[j][1]))), fmaxf(fabsf(v[j][2]), fabsf(v[j][3])));
    am = wave_max(am);
    const float sc = am > 0.f ? am * (1.f / 127.f) : 1.f, inv = am > 0.f ? 127.f / am : 0.f;
#pragma unroll
    for (int j = 0; j < 8; ++j) { u32x2 o; o.x = cvt_pk_bf16(v[j][0], v[j][1]); o.y = cvt_pk_bf16(v[j][2], v[j][3]); *(u32x2*)(xf + 256 * j + 4 * lane) = o; *(unsigned*)(xq + 256 * j + 4 * lane) = pack_i8x4(v[j][0] * inv, v[j][1] * inv, v[j][2] * inv, v[j][3] * inv); }
    if (lane == 0) *sxp = sc;
}
__device__ __forceinline__ void ln_phase(Frame& F, const bf16_t* u, const float* g, const float* b) {
    const int lane_ = lane_id(), tid_ = F.wave * 64 + lane_; (void)tid_;
    bf16_t* XF = (bf16_t*)(F.ws + WS_XF); i8_t* XQ = (i8_t*)(F.ws + WS_XB); float* SX = (float*)(F.ws + WS_SX);
    const int gw = F.vcu * NWAVES + F.wave, NGW = F.G * NWAVES;
    u32x2 nw[8];
    if (gw < M) {
#pragma unroll
        for (int j = 0; j < 8; ++j) nw[j] = *(const u32x2*)(u + (size_t)gw * DM + 256 * j + 4 * lane_); }
    for (int m = gw; m < M; m += NGW) { f32x4 v[8];
#pragma unroll
        for (int j = 0; j < 8; ++j) v[j] = bf16x4_to_f32(nw[j]);
        { const int mn = (m + NGW < M) ? m + NGW : m;
#pragma unroll
          for (int j = 0; j < 8; ++j) nw[j] = *(const u32x2*)(u + (size_t)mn * DM + 256 * j + 4 * lane_); }
        ln_inplace(v, g, b, lane_);
        store_row_f32_q(v, XF + (size_t)m * DM, XQ + (size_t)m * DM, SX + m, lane_); }
}
__device__ __forceinline__ void ln_router_phase(Frame& F, const bf16_t* u, const float* g, const float* b) {
    const int lane_ = lane_id(), tid_ = F.wave * 64 + lane_; (void)tid_;
    bf16_t* XF = (bf16_t*)(F.ws + WS_XF); i8_t* XQ = (i8_t*)(F.ws + WS_XB); float* SX = (float*)(F.ws + WS_SX);
    int* tokE = (int*)(F.ws + WS_TOKE); float* tokG = (float*)(F.ws + WS_TOKG); int* tokR = (int*)(F.ws + WS_TOKR);
    LAS float* wr = (LAS float*)(F.lds + RING_OFF);
    LAS int* lcnt = (LAS int*)(F.lds + RING_OFF + 65536);
    for (int i = tid_; i < DM * NE / 4; i += NTHREADS) ((LAS f32x4*)wr)[i] = ((const f32x4*)F.in(I_MR))[i];
    if (tid_ < 16) lcnt[tid_] = 0;
    __syncthreads();
    const int rows_per_wg = (M + F.G - 1) / F.G, m0 = F.vcu * rows_per_wg; int m1 = m0 + rows_per_wg; if (m1 > M) m1 = M;
    u32x2 nw[8];
    if (m0 + F.wave < m1) {
#pragma unroll
        for (int j = 0; j < 8; ++j) nw[j] = *(const u32x2*)(u + (size_t)(m0 + F.wave) * DM + 256 * j + 4 * lane_); }
    for (int m = m0 + F.wave; m < m1; m += NWAVES) { f32x4 v[8];
#pragma unroll
        for (int j = 0; j < 8; ++j) v[j] = bf16x4_to_f32(nw[j]);
        { const int mn = (m + NWAVES < m1) ? m + NWAVES : m;
#pragma unroll
          for (int j = 0; j < 8; ++j) nw[j] = *(const u32x2*)(u + (size_t)mn * DM + 256 * j + 4 * lane_); }
        ln_inplace(v, g, b, lane_);
        store_row_f32_q(v, XF + (size_t)m * DM, XQ + (size_t)m * DM, SX + m, lane_);
        float lg[8];
#pragma unroll
        for (int e = 0; e < 8; ++e) lg[e] = 0.f;
#pragma unroll
        for (int j = 0; j < 8; ++j)
#pragma unroll
            for (int i = 0; i < 4; ++i) { const int k = 256 * j + 4 * lane_ + i; const f32x4 w0 = *(const LAS f32x4*)(wr + k * 8), w1 = *(const LAS f32x4*)(wr + k * 8 + 4); const float xv = v[j][i];
                lg[0] += xv * w0[0]; lg[1] += xv * w0[1]; lg[2] += xv * w0[2]; lg[3] += xv * w0[3]; lg[4] += xv * w1[0]; lg[5] += xv * w1[1]; lg[6] += xv * w1[2]; lg[7] += xv * w1[3]; }
#pragma unroll
        for (int e = 0; e < 8; ++e) lg[e] = wave_sum(lg[e]);
        float b0 = lg[0]; int e0 = 0;
#pragma unroll
        for (int e = 1; e < 8; ++e) if (lg[e] > b0) { b0 = lg[e]; e0 = e; }
        float b1 = -__builtin_inff(); int e1 = 0;
#pragma unroll
        for (int e = 0; e < 8; ++e) if (e != e0 && lg[e] > b1) { b1 = lg[e]; e1 = e; }
        if (lane_ == 0) { const float g1 = 1.0f / (1.0f + __expf(b0 - b1)), g0 = 1.0f - g1;
            const int r0 = atomicAdd((int*)&lcnt[e0], 1), r1 = atomicAdd((int*)&lcnt[e1], 1);
            tokE[2 * m] = e0; tokE[2 * m + 1] = e1; tokG[2 * m] = g0; tokG[2 * m + 1] = g1;
            LAS int* lr = lcnt + 16 + 4 * (m - m0); lr[0] = e0; lr[1] = e1; lr[2] = r0; lr[3] = r1; }
    }
    __syncthreads();
    if (tid_ < 8) lcnt[8 + tid_] = (int)__hip_atomic_fetch_add(F.ctl + CW_CNT + tid_, (unsigned)lcnt[tid_], RLX_AGENT);
    __syncthreads();
    for (int t = tid_; t < 2 * (m1 - m0); t += NTHREADS) { const LAS int* lr = lcnt + 16 + 4 * (t >> 1); const int e = lr[t & 1]; tokR[2 * m0 + t] = lr[2 + (t & 1)] + lcnt[8 + e]; }
}
__device__ __forceinline__ void moe_layout(Frame& F) {
    const int lane_ = lane_id(), tid_ = F.wave * 64 + lane_; (void)tid_;
    if (tid_ == 0) { unsigned rs = 0, ts = 0;
        for (int e = 0; e < NE; ++e) { const unsigned c = __hip_atomic_load(F.ctl + CW_CNT + e, RLX_AGENT), nt = (c + 255u) >> 8; F.MISC[16 + e] = rs; F.MISC[32 + e] = ts; rs += nt * 256u; ts += nt; }
        F.MISC[16 + NE] = rs; F.MISC[32 + NE] = ts; }
    __syncthreads();
}
__device__ __forceinline__ void gather_phase(Frame& F) {
    const int lane_ = lane_id(), tid_ = F.wave * 64 + lane_; (void)tid_;
    const i8_t* XQ = (const i8_t*)(F.ws + WS_XB); i8_t* XS = (i8_t*)(F.ws + WS_XS); const float* SX = (const float*)(F.ws + WS_SX); float* SXS = (float*)(F.ws + WS_SXS);
    const int* tokE = (const int*)(F.ws + WS_TOKE); const int* tokR = (const int*)(F.ws + WS_TOKR); int* tokP = (int*)(F.ws + WS_TOKP);
    const int gw = F.vcu * NWAVES + F.wave, NGW = F.G * NWAVES;
    int ne0 = 0, ne1 = 0, nr0 = 0, nr1 = 0; float nsc = 0.f; u32x4 nv0 = (u32x4){0u, 0u, 0u, 0u}, nv1 = nv0;
    if (gw < M) { ne0 = tokE[2 * gw]; ne1 = tokE[2 * gw + 1]; nr0 = tokR[2 * gw]; nr1 = tokR[2 * gw + 1]; nsc = SX[gw];
        const u32x4* src = (const u32x4*)(XQ + (size_t)gw * DM); nv0 = src[lane_]; nv1 = src[64 + lane_]; }
    for (int m = gw; m < M; m += NGW) {
        const int e0 = ne0, e1 = ne1, r0 = nr0, r1 = nr1; const float sc = nsc; const u32x4 v0 = nv0, v1 = nv1;
        { const int mn = (m + NGW < M) ? m + NGW : m; ne0 = tokE[2 * mn]; ne1 = tokE[2 * mn + 1]; nr0 = tokR[2 * mn]; nr1 = tokR[2 * mn + 1]; nsc = SX[mn];
          const u32x4* src = (const u32x4*)(XQ + (size_t)mn * DM); nv0 = src[lane_]; nv1 = src[64 + lane_]; }
        const int p0 = (int)F.MISC[16 + e0] + r0, p1 = (int)F.MISC[16 + e1] + r1;
        if (lane_ == 0) { tokP[2 * m] = p0; tokP[2 * m + 1] = p1; SXS[p0] = sc; SXS[p1] = sc; }
        u32x4* d0 = (u32x4*)(XS + (size_t)p0 * DM); u32x4* d1 = (u32x4*)(XS + (size_t)p1 * DM);
        d0[lane_] = v0; d1[lane_] = v0; d0[64 + lane_] = v1; d1[64 + lane_] = v1; }
}
__device__ __forceinline__ void final_phase(Frame& F, const float* g, const float* b, const int mode, const int limit) {
    const int lane_ = lane_id();
    const bf16_t* XF = (const bf16_t*)(F.ws + WS_XF); const bf16_t* OE = (const bf16_t*)(F.ws + WS_OE);
    const float* tokG = (const float*)(F.ws + WS_TOKG); const int* tokP = (const int*)(F.ws + WS_TOKP);
    unsigned* done = F.ctl + CW_DONE;
    const int gw = F.vcu * NWAVES + F.wave, NGW = F.G * NWAVES, s = NGW / 8 + 8;
    for (int k = 0; k * NGW < M; ++k) {
        const int m = (mode == 0 ? gw : (gw + s * k) % NGW) + NGW * k; if (m >= M) continue;
        const int p0 = __builtin_amdgcn_readfirstlane(tokP[2 * m]), p1 = __builtin_amdgcn_readfirstlane(tokP[2 * m + 1]);
        if (mode == 0) { if (p0 >= limit || p1 >= limit) continue; }
        else { if (__builtin_amdgcn_readfirstlane((int)done[m]) != 0) continue; }
        f32x4 v[8];
        const float g0 = tokG[2 * m], g1 = tokG[2 * m + 1];
#pragma unroll
        for (int j = 0; j < 8; ++j) { const int col = 256 * j + 4 * lane_; const f32x4 xv = ld_bf16x4(XF + (size_t)m * DM + col);
            const u32x2 a = *(const u32x2*)(OE + (size_t)p0 * DM + col), c = *(const u32x2*)(OE + (size_t)p1 * DM + col);
            f32x4 fa, fc; fa[0] = __uint_as_float(a.x << 16); fa[1] = __uint_as_float(a.x & 0xffff0000u); fa[2] = __uint_as_float(a.y << 16); fa[3] = __uint_as_float(a.y & 0xffff0000u);
            fc[0] = __uint_as_float(c.x << 16); fc[1] = __uint_as_float(c.x & 0xffff0000u); fc[2] = __uint_as_float(c.y << 16); fc[3] = __uint_as_float(c.y & 0xffff0000u);
            v[j] = xv * ALPHA + fa * g0 + fc * g1; }
        ln_inplace(v, g, b, lane_);
#pragma unroll
        for (int j = 0; j < 8; ++j) *(f32x4*)(F.out + (size_t)m * DM + 256 * j + 4 * lane_) = v[j];
        if (mode == 0 && lane_ == 0) done[m] = 1u;
    }
}
__device__ __forceinline__ void kmean_phase(Frame& F) {
    const int lane_ = lane_id(), tid_ = F.wave * 64 + lane_; (void)tid_;
    const bf16_t* Kh = (const bf16_t*)(F.ws + WS_K); bf16_t* KM = (bf16_t*)(F.ws + WS_KMEAN);
    const int gw = F.vcu * NWAVES + F.wave, NGW = F.G * NWAVES;
    for (int it = gw; it < NB * NH * NBLK; it += NGW) { const u32x4* p = (const u32x4*)(Kh + (size_t)it * 256 * HD) + lane_; float s[8];
#pragma unroll
        for (int k = 0; k < 8; ++k) s[k] = 0.f;
#pragma unroll 16
        for (int r = 0; r < 64; ++r) { const u32x4 w = p[r * 64];
            s[0] += __uint_as_float(w.x << 16); s[1] += __uint_as_float(w.x & 0xffff0000u); s[2] += __uint_as_float(w.y << 16); s[3] += __uint_as_float(w.y & 0xffff0000u);
            s[4] += __uint_as_float(w.z << 16); s[5] += __uint_as_float(w.z & 0xffff0000u); s[6] += __uint_as_float(w.w << 16); s[7] += __uint_as_float(w.w & 0xffff0000u); }
#pragma unroll
        for (int k = 0; k < 8; ++k) { s[k] += __shfl_xor(s[k], 16); s[k] += __shfl_xor(s[k], 32); }
        if (lane_ < 16) { u32x4 o; o.x = cvt_pk_bf16(s[0] * (1.f / 256.f), s[1] * (1.f / 256.f)); o.y = cvt_pk_bf16(s[2] * (1.f / 256.f), s[3] * (1.f / 256.f));
            o.z = cvt_pk_bf16(s[4] * (1.f / 256.f), s[5] * (1.f / 256.f)); o.w = cvt_pk_bf16(s[6] * (1.f / 256.f), s[7] * (1.f / 256.f)); ((u32x4*)(KM + (size_t)it * HD))[lane_] = o; } }
    if (F.vcu == 0 && tid_ == 0) { float* scl = (float*)(F.ws + WS_SCL); const unsigned eb = (__hip_atomic_load(F.ctl + CW_VMAX, RLX_AGENT) >> 23) & 0xffu;
        const float so = (eb < 16u || eb > 240u) ? 1.0f : __uint_as_float((261u - eb) << 23);
        scl[NE + 2] = so; scl[NE + 3] = so * scl[NE + 1]; }
}

struct SchedDense {
    pg8::TileOrder T; const char* A; const char* B; size_t astep, bstep;
    __device__ __forceinline__ bool next(int i, pg8::Unit& u) const { int pm, pn; if (!T.pmpn(i, pm, pn)) return false; u.pm = pm; u.pn = pn; u.aux = 0; u.A = A + (size_t)pm * astep; u.B = B + (size_t)pn * bstep; return true; }
};
struct SchedPool {
    pg8::TileOrder T; const char* A; const char* B;
    __device__ __forceinline__ bool next(int i, pg8::Unit& u) const { int pm, pn; if (!T.pmpn(i, pm, pn)) return false; u.pm = pm; u.pn = pn; u.aux = pn >> 1;
        u.A = A + ((size_t)pm * 256 * DM + (size_t)(pn >> 1) * PGC) * 2; u.B = B + ((size_t)(pn >> 1) * PGC * PGC + (size_t)(pn & 1) * 256 * PGC) * 2; return true; }
};
struct SchedMoe {
    pg8::TileOrder T; const char* A; const char* B; size_t astep, bstep, estep; volatile LAS unsigned* ts; int pm0;
    __device__ __forceinline__ bool next(int i, pg8::Unit& u) const { int pm, pn; if (!T.pmpn(i, pm, pn)) return false; pm += pm0; u.pm = pm; u.pn = pn;
        int e = 0;
#pragma unroll
        for (int k = 1; k < NE; ++k) e += ((unsigned)pm >= (unsigned)__builtin_amdgcn_readfirstlane((int)ts[k])) ? 1 : 0;
        u.aux = e; u.A = A + (size_t)pm * astep; u.B = B + (size_t)e * estep + (size_t)pn * bstep; return true; }
};

struct Args { const float* in[17]; float* out; unsigned char* ws; int ph_lo, ph_hi; };
constexpr int N_PHASES = 16;
__global__ void __launch_bounds__(NTHREADS, 2) fwd_kernel(Args args) {
    extern __shared__ __attribute__((aligned(16))) unsigned char lds[];
    Frame F;
    F.lds = (LAS unsigned char*)lds;
    F.MISC = (volatile LAS unsigned*)(F.lds + MISC_OFF);
    F.wave = __builtin_amdgcn_readfirstlane((int)(threadIdx.x >> 6));
    const int lane_ = lane_id(), tid_ = F.wave * 64 + lane_;
    F.G = gridDim.x; { const int bx = blockIdx.x; F.vcu = (F.G % 8 == 0) ? (bx % 8) * (F.G / 8) + bx / 8 : bx; }
    F.ws = args.ws; F.ctl = (unsigned*)(args.ws + WS_CTL);
    F.out = args.out;
    for (int u = tid_; u < (LDS_BYTES - LDSCTL_OFF) / 4; u += NTHREADS) ((LAS unsigned*)(F.lds + LDSCTL_OFF))[u] = 0u;
    if (tid_ < 17) { const unsigned long long pv = (unsigned long long)args.in[tid_]; F.MISC[64 + 2 * tid_] = (unsigned)pv; F.MISC[64 + 2 * tid_ + 1] = (unsigned)(pv >> 32); }
    __syncthreads();
    XcdBarrier bar; bar.bar = F.ctl + CW_BAR; bar.x = 0; bar.st = nullptr;
    if (MK_N_LAUNCHES == 1) bar = xcd_barrier_post(F.ctl + CW_BAR, F.MISC + 8, tid_ == 0);
    const int lo = args.ph_lo, hi = args.ph_hi;
#define IN(k) (lo <= (k) && (k) < hi)
#define REPS(k) for (int rep_ = 0; rep_ < ((PROBE_DUP == (k)) ? 2 : 1); ++rep_)
#define SEAM(k) do { if (IN(k) && IN((k) + 1)) xcd_barrier(bar, F.wave); } while (0)
    unsigned char* ws = args.ws;
    const char* XQ = (const char*)(ws + WS_XB); const bf16_t* XF = (const bf16_t*)(ws + WS_XF); bf16_t* U = (bf16_t*)args.out; const float* SX = (const float*)(ws + WS_SX);
    const int cid = (int)blockIdx.x;

    if (IN(0)) REPS(0) {
        convert_family(F, F.in(I_POOLW), PGC, PGC, (size_t)PGC * PGC, (bf16_t*)(ws + WS_WPOOL), (size_t)PGC * PGC, 4);
        down_scale_sample(F);
        __syncthreads();
        quant_weights(F);
        rope_tables(F);
        pool_diff(F);
    }
    SEAM(0);
    if (IN(1)) REPS(1) {
        SchedPool S; S.T.init(M / 256, DM / 256, F.G, cid); S.A = (const char*)(ws + WS_DIFF); S.B = (const char*)(ws + WS_WPOOL);
        pg8::EpiRes<true> E{(const void*)F.in(I_X), U, DM, F.in(I_POOLS), nullptr};
        pg8::gemm_phase<0, pg8::EpiRes<true>, SchedPool, true>(F.lds + RING_OFF, pg8::GemmP{PGC / 64, DM * 2, PGC * 2}, S, E, F.wave);
    }
    SEAM(1);
    if (IN(2)) REPS(2) { ln_phase(F, U, F.in(I_LMG), F.in(I_LMB)); __syncthreads();
        down_quant(F, F.lds + RING_OFF, F.in(I_FD), DFF, 1, (const float*)(ws + WS_SCL) + NE, ws + WS_WD, 0, ((DFF / 512) * (DM / 64) + F.G - 1) / F.G);
        down_quant(F, F.lds + RING_OFF, F.in(I_WO), DM, 1, (const float*)(ws + WS_SCL) + NE + 1, ws + WS_WO, 0, ((DM / 512) * (DM / 64) + F.G - 1) / F.G); }
    SEAM(2);
    if (IN(3)) REPS(3) {
        SchedDense S; S.T.init(M / 256, 2 * DFF / 256, F.G, cid); S.A = XQ; S.B = (const char*)(ws + WS_WGU); S.astep = (size_t)256 * DM; S.bstep = (size_t)256 * DM;
        pg8::EpiSwiGLU<true> E{(void*)(ws + WS_HFFN), DFF, SX, (const float*)(ws + WS_SWGU), 0};
        pg8::gemm_phase<1, pg8::EpiSwiGLU<true>, SchedDense, true>(F.lds + RING_OFF, pg8::GemmP{DM / 128, DM, DM}, S, E, F.wave);
    }
    SEAM(3);
    if (IN(4)) REPS(4) {
        SchedDense S; S.T.init(M / 256, DM / 256, F.G, cid, WGM_BIGK); S.A = (const char*)(ws + WS_HFFN); S.B = (const char*)(ws + WS_WD); S.astep = (size_t)256 * DFF; S.bstep = (size_t)256 * DFF;
        pg8::EpiRes<false> E{(const void*)XF, U, DM, nullptr, (const float*)(ws + WS_SCL) + NE};
        pg8::gemm_phase<2, pg8::EpiRes<false>, SchedDense, true>(F.lds + RING_OFF, pg8::GemmP{DFF / 128, DFF, DFF}, S, E, F.wave);
    }
    SEAM(4);
    if (IN(5)) REPS(5) ln_phase(F, U, F.in(I_LFG), F.in(I_LFB));
    SEAM(5);
    if (IN(6)) REPS(6) {
        SchedDense S; S.T.init(M / 256, 3 * DM / 256, F.G, cid); S.A = XQ; S.B = (const char*)(ws + WS_WQKV); S.astep = (size_t)256 * DM; S.bstep = (size_t)256 * DM;
        pg8::EpiQKV E{(bf16_t*)(ws + WS_Q), (bf16_t*)(ws + WS_K), (bf16_t*)(ws + WS_V), (const float*)(ws + WS_COS), (const float*)(ws + WS_SIN), SX, (const float*)(ws + WS_SWQKV), F.ctl + CW_VMAX};
        pg8::gemm_phase<1, pg8::EpiQKV, SchedDense, true>(F.lds + RING_OFF, pg8::GemmP{DM / 128, DM, DM}, S, E, F.wave);
    }
    SEAM(6);
    if (IN(7)) REPS(7) kmean_phase(F);
    SEAM(7);
    if (IN(8)) REPS(8) {
        struct MoeSide { Frame& F; __device__ __forceinline__ void operator()(int slot, int nslots) const { moe_side_work(F, slot, nslots); } };
        att::attn_phase((char*)lds + RING_OFF, ws, F.G, F.vcu, F.wave, MoeSide{F});
    }
    SEAM(8);
    if (IN(9)) REPS(9) {
        SchedDense S; S.T.init(M / 256, DM / 256, F.G, cid); S.A = (const char*)(ws + WS_O); S.B = (const char*)(ws + WS_WO); S.astep = (size_t)256 * DM; S.bstep = (size_t)256 * DM;
        pg8::EpiRes<false> E{(const void*)XF, U, DM, nullptr, (const float*)(ws + WS_SCL) + NE + 3};
        pg8::gemm_phase<2, pg8::EpiRes<false>, SchedDense, true>(F.lds + RING_OFF, pg8::GemmP{DM / 128, DM, DM}, S, E, F.wave);
    }
    SEAM(9);
    if (IN(10)) ln_router_phase(F, U, F.in(I_LMG) + DM, F.in(I_LMB) + DM);
    SEAM(10);
    if (IN(11)) REPS(11) { moe_layout(F); gather_phase(F); }
    SEAM(11);
    if (IN(12)) REPS(12) {
        moe_layout(F);
        SchedMoe S; S.T.init(__builtin_amdgcn_readfirstlane((int)F.MISC[32 + NE]), 2 * DFE / 256, F.G, cid); S.A = (const char*)(ws + WS_XS); S.B = (const char*)(ws + WS_MWGU);
        S.astep = (size_t)256 * DM; S.bstep = (size_t)256 * DM; S.estep = (size_t)2 * DFE * DM; S.ts = F.MISC + 32; S.pm0 = 0;
        pg8::EpiSwiGLU<true> E{(void*)(ws + WS_HMOE), DFE, (const float*)(ws + WS_SXS), (const float*)(ws + WS_SWM), 2 * DFE};
        pg8::gemm_phase<1, pg8::EpiSwiGLU<true>, SchedMoe, true>(F.lds + RING_OFF, pg8::GemmP{DM / 128, DM, DM}, S, E, F.wave);
    }
    SEAM(12);
    if (IN(13)) REPS(13) {
        moe_layout(F);
        const int nRT = __builtin_amdgcn_readfirstlane((int)F.MISC[32 + NE]), nRTa = (nRT / (F.G / 8)) * (F.G / 8);
        SchedMoe S; S.T.init(nRTa, DM / 256, F.G, cid, WGM_BIGK); S.A = (const char*)(ws + WS_HMOE); S.B = (const char*)(ws + WS_MWD);
        S.astep = (size_t)256 * DFE; S.bstep = (size_t)256 * DFE; S.estep = (size_t)DM * DFE; S.ts = F.MISC + 32; S.pm0 = 0;
        pg8::EpiBf16 E{(bf16_t*)(ws + WS_OE), DM, (const float*)(ws + WS_SCL)};
        pg8::gemm_phase<2, pg8::EpiBf16, SchedMoe, true>(F.lds + RING_OFF, pg8::GemmP{DFE / 128, DFE, DFE}, S, E, F.wave);
    }
    SEAM(13);
    if (IN(14)) REPS(14) {
        moe_layout(F);
        const int nRT = __builtin_amdgcn_readfirstlane((int)F.MISC[32 + NE]), nRTa = (nRT / (F.G / 8)) * (F.G / 8);
        if (cid < (nRT - nRTa) * (DM / 256)) {
            SchedMoe S; S.T.init(nRT - nRTa, DM / 256, F.G, cid, WGM_BIGK); S.A = (const char*)(ws + WS_HMOE); S.B = (const char*)(ws + WS_MWD);
            S.astep = (size_t)256 * DFE; S.bstep = (size_t)256 * DFE; S.estep = (size_t)DM * DFE; S.ts = F.MISC + 32; S.pm0 = nRTa;
            pg8::EpiBf16 E{(bf16_t*)(ws + WS_OE), DM, (const float*)(ws + WS_SCL)};
            pg8::gemm_phase<2, pg8::EpiBf16, SchedMoe, true>(F.lds + RING_OFF, pg8::GemmP{DFE / 128, DFE, DFE}, S, E, F.wave);
        } else final_phase(F, F.in(I_LFG) + DM, F.in(I_LFB) + DM, 0, nRTa * 256);
    }
    SEAM(14);
    if (IN(15)) REPS(15) final_phase(F, F.in(I_LFG) + DM, F.in(I_LFB) + DM, 1, 0);
#undef IN
#undef SEAM
}

extern "C" void kernel_launch(void* const* d_in, const int* in_sizes, int n_in, void* d_out, int out_size, void* d_ws, size_t ws_size, hipStream_t stream) {
    static int grid = 0;
    if (grid == 0) {
        if (n_in != 17 || in_sizes[0] != M * DM || out_size != M * DM || ws_size < WS_END) { fprintf(stderr, "kernel_launch: unexpected shapes (n_in %d, in0 %d, out %d, ws %zu); nothing launched\n", n_in, n_in > 0 ? in_sizes[0] : -1, out_size, ws_size); grid = -1; return; }
        int dev = 0, cus = 0, per_cu = 0;
        if (hipGetDevice(&dev) != hipSuccess || hipDeviceGetAttribute(&cus, hipDeviceAttributeMultiprocessorCount, dev) != hipSuccess) { grid = -1; return; }
        if (hipFuncSetAttribute((const void*)fwd_kernel, hipFuncAttributeMaxDynamicSharedMemorySize, LDS_BYTES) != hipSuccess) { fprintf(stderr, "kernel_launch: hipFuncSetAttribute failed\n"); grid = -1; return; }
        if (hipOccupancyMaxActiveBlocksPerMultiprocessor(&per_cu, (const void*)fwd_kernel, NTHREADS, LDS_BYTES) != hipSuccess || per_cu < 1) { fprintf(stderr, "kernel_launch: occupancy query says %d blocks per CU\n", per_cu); (void)hipGetLastError(); }
        grid = cus;
    }
    if (grid < 0) return;
    (void)hipMemsetAsync((char*)d_ws + WS_CTL, 0, CTL_ZERO_BYTES, stream);
    Args a{};
    for (int i = 0; i < 17; ++i) a.in[i] = (const float*)d_in[i];
    a.out = (float*)d_out; a.ws = (unsigned char*)d_ws;
#if MK_N_LAUNCHES == 1
    a.ph_lo = 0; a.ph_hi = N_PHASES;
    hipLaunchKernelGGL(fwd_kernel, dim3(grid), dim3(NTHREADS), LDS_BYTES, stream, a);
    if (PROBE_RELAUNCH >= 0) { a.ph_lo = PROBE_RELAUNCH; a.ph_hi = PROBE_RELAUNCH + 1; hipLaunchKernelGGL(fwd_kernel, dim3(grid), dim3(NTHREADS), LDS_BYTES, stream, a); }
#else
    for (int p = 0; p < N_PHASES; ++p) { a.ph_lo = p; a.ph_hi = p + 1; hipLaunchKernelGGL(fwd_kernel, dim3(grid), dim3(NTHREADS), LDS_BYTES, stream, a); }
#endif
}
```

```cpp
#include <hip/hip_runtime.h>
#include <cstdio>
#include <cstdint>

#define LAS __attribute__((address_space(3)))
#define GAS __attribute__((address_space(1)))
typedef unsigned short bf16_t;
typedef short bf16x8 __attribute__((ext_vector_type(8)));
typedef short s16x4 __attribute__((ext_vector_type(4)));
typedef float f32x2 __attribute__((ext_vector_type(2)));
typedef float f32x4 __attribute__((ext_vector_type(4)));
typedef float f32x16 __attribute__((ext_vector_type(16)));
typedef unsigned u32x2 __attribute__((ext_vector_type(2)));
typedef unsigned u32x4 __attribute__((ext_vector_type(4)));
typedef int i32x4 __attribute__((ext_vector_type(4)));
typedef int i32x8 __attribute__((ext_vector_type(8)));
typedef signed char i8_t;

#ifndef PROBE_DUP
#define PROBE_DUP -1
#endif
#ifndef PROBE_RELAUNCH
#define PROBE_RELAUNCH -1
#endif
#ifndef MK_N_LAUNCHES
#define MK_N_LAUNCHES 1
#endif

constexpr int NB = 4, SEQ = 4096, DM = 2048, NH = 16, HD = 128, M = NB * SEQ;
constexpr int DFF = 5632, NE = 8, DFE = 7168, NBLK = SEQ / 256, PGC = 512;
constexpr float ALPHA = 1.4142135623730951f, LN_EPS = 1e-5f;
constexpr int PMAX = 2 * M + NE * 256;
constexpr int NWAVES = 8, NTHREADS = 512;

constexpr size_t MiB = 1u << 20;
constexpr size_t WS_CTL = 0, CTL_ZERO_BYTES = 1 * MiB;
constexpr size_t WS_COS = 1 * MiB, WS_SIN = 2 * MiB;
constexpr size_t WS_KMEAN = 3 * MiB;
constexpr size_t WS_SCL = 3 * MiB + 512 * 1024;
constexpr size_t WS_TOKE = 4 * MiB, WS_TOKG = WS_TOKE + 128 * 1024, WS_TOKR = WS_TOKG + 128 * 1024, WS_TOKP = WS_TOKR + 128 * 1024;
constexpr size_t WS_SWQKV = 5 * MiB, WS_SWGU = WS_SWQKV + 32 * 1024, WS_SX = WS_SWQKV + 96 * 1024, WS_SXS = WS_SWQKV + 160 * 1024, WS_SWM = WS_SWQKV + 512 * 1024;
constexpr size_t WS_SWD = WS_SWQKV + 960 * 1024;
constexpr size_t WS_WPOOL = 6 * MiB;
constexpr size_t WS_WQKV = 8 * MiB;
constexpr size_t WS_WO = 32 * MiB;
constexpr size_t WS_WGU = 40 * MiB;
constexpr size_t WS_WD = 84 * MiB;
constexpr size_t WS_MWGU = 106 * MiB;
constexpr size_t WS_MWD = 554 * MiB;
constexpr size_t WS_XF = 778 * MiB;
constexpr size_t WS_XB = 906 * MiB;
constexpr size_t WS_XS = 970 * MiB;
constexpr size_t WS_OE = 1106 * MiB;
constexpr size_t WS_A = 1242 * MiB;
constexpr size_t WS_DIFF = WS_A, WS_HFFN = WS_A + 64 * MiB, WS_Q = WS_A + 240 * MiB, WS_K = WS_A + 304 * MiB, WS_V = WS_A + 368 * MiB, WS_O = WS_A + 432 * MiB;
constexpr size_t WS_HMOE = WS_A;
constexpr size_t WS_END = 1738 * MiB;
static_assert((size_t)PMAX * DFE * 2 <= 496 * MiB && (size_t)PMAX * DM * 2 <= 136 * MiB, "ws map");
constexpr int CW_TMO = 0, CW_CODE = 1;
constexpr int CW_CNT = 64;
constexpr int CW_VMAX = 80;
constexpr int CW_BAR = 4096;
constexpr int CW_DONE = 65536;
constexpr int CW_CMAX = 16384;

constexpr int RING_OFF = 0, RING_BYTES = 131072;
constexpr int LDS_BYTES = 147456;
constexpr int LDSCTL_OFF = LDS_BYTES - 2048, MISC_OFF = LDSCTL_OFF + 320;
static_assert(75776 + 32 * 2064 + 1024 <= LDSCTL_OFF, "LDS map");
constexpr int SIDE_OFF = 75776;

#define RLX_AGENT __ATOMIC_RELAXED, __HIP_MEMORY_SCOPE_AGENT
#define LDS_WAIT() asm volatile("s_waitcnt lgkmcnt(0)" ::: "memory")
#define VM_WAIT() asm volatile("s_waitcnt vmcnt(0)" ::: "memory")

__device__ __forceinline__ unsigned cvt_pk_bf16(float lo, float hi) { unsigned r; asm volatile("v_cvt_pk_bf16_f32 %0, %1, %2" : "=v"(r) : "v"(lo), "v"(hi)); return r; }
__device__ __forceinline__ float bf2f(unsigned short b) { return __uint_as_float((unsigned)b << 16); }
__device__ __forceinline__ int lane_id() { int l; asm volatile("v_mbcnt_lo_u32_b32 %0, -1, 0\n\tv_mbcnt_hi_u32_b32 %0, -1, %0" : "=v"(l)); return l; }
__device__ __forceinline__ float wave_sum(float v) {
#pragma unroll
    for (int o = 1; o < 64; o <<= 1) v += __shfl_xor(v, o);
    return v;
}

__device__ __forceinline__ float quad_xor1(float v) { return __int_as_float(__builtin_amdgcn_update_dpp(0, __float_as_int(v), 0xB1, 0xf, 0xf, false)); }
__device__ __forceinline__ float quad_xor2(float v) { return __int_as_float(__builtin_amdgcn_update_dpp(0, __float_as_int(v), 0x4E, 0xf, 0xf, false)); }
__device__ __forceinline__ float wave_max(float v) {
#pragma unroll
    for (int o = 1; o < 64; o <<= 1) v = fmaxf(v, __shfl_xor(v, o));
    return v;
}
__device__ __forceinline__ unsigned pack_i8x4(float a, float b, float c, float d) {
    const unsigned ua = __float_as_uint(a + 12582912.f), ub = __float_as_uint(b + 12582912.f), uc = __float_as_uint(c + 12582912.f), ud = __float_as_uint(d + 12582912.f);
    return __builtin_amdgcn_perm(ub, ua, 0x0c0c0400u) | __builtin_amdgcn_perm(ud, uc, 0x04000c0cu);
}

#define XB_TMO      128
#define XB_XCNT(j)  (256  + 64 * (j))
#define XB_XSUB(j)  (1280 + 64 * (j))
#define XB_XGEN(j)  (2304 + 64 * (j))
#define XB_TOP      3328
#define XB_TOPGEN   3392
#define XCD_BAR_WORDS 3456
#define XB_SPIN_CAP (1u << 20)
__device__ __forceinline__ unsigned xb_ld(unsigned* p)              { return __hip_atomic_load(p, __ATOMIC_RELAXED, __HIP_MEMORY_SCOPE_AGENT); }
__device__ __forceinline__ unsigned xb_add(unsigned* p, unsigned v) { return __hip_atomic_fetch_add(p, v, __ATOMIC_RELAXED, __HIP_MEMORY_SCOPE_AGENT); }
__device__ __forceinline__ unsigned xb_xcc_id() { return (unsigned)__builtin_amdgcn_s_getreg((3 << 11) | 20) & 0xFu; }
#define XB_SPIN(cond, bar) do { unsigned _sp = 0; while (cond) { __builtin_amdgcn_s_sleep(1); \
    if ((++_sp & 255u) == 0u) { if (xb_ld(&(bar)[XB_TMO])) break; if (_sp > XB_SPIN_CAP) { atomicAdd(&(bar)[XB_TMO], 1u); break; } } } } while (0)
struct XcdBarrier { unsigned* bar; unsigned x; volatile LAS unsigned* st; };
__device__ __forceinline__ XcdBarrier xcd_barrier_post(unsigned* bar, volatile LAS unsigned* st, bool leader) {
    XcdBarrier b; b.bar = bar; b.x = xb_xcc_id(); b.st = st;
    if (leader) (void)xb_add(&bar[XB_XCNT(b.x)], 1u);
    return b;
}
__device__ __forceinline__ void xcd_barrier_complete(unsigned* bar, unsigned x, unsigned& nloc, unsigned& nx) {
    const unsigned G = gridDim.x * gridDim.y * gridDim.z;
    unsigned sum, cnt, mine, sp = 0u;
    for (;;) {
        sum = 0u; cnt = 0u; mine = 0u;
#pragma unroll
        for (unsigned j = 0; j < 16; ++j) { const unsigned c = xb_ld(&bar[XB_XCNT(j)]); sum += c; cnt += (c > 0u) ? 1u : 0u; mine = (j == x) ? c : mine; }
        if (sum == G) break;
        __builtin_amdgcn_s_sleep(1);
        if ((++sp & 255u) == 0u) { if (xb_ld(&bar[XB_TMO])) break; if (sp > XB_SPIN_CAP) { atomicAdd(&bar[XB_TMO], 1u); break; } }
    }
    nloc = mine > 0u ? mine : 1u; nx = cnt > 0u ? cnt : 1u;
}
__device__ __forceinline__ void xcd_barrier(const XcdBarrier& b, int wave) {
    asm volatile("s_waitcnt vmcnt(0)" ::: "memory");
    __syncthreads();
    if (wave == 0 && lane_id() == 0) {
        unsigned* bar = b.bar;
        __builtin_amdgcn_s_waitcnt(0);
        unsigned nloc = b.st[0], nx = b.st[1];
        if (nloc == 0u) { xcd_barrier_complete(bar, b.x, nloc, nx); b.st[0] = nloc; b.st[1] = nx; }
        const unsigned old = xb_add(&bar[XB_XSUB(b.x)], 1u);
        const unsigned gen = old / nloc;
        if (old + 1u == (gen + 1u) * nloc) {
            __builtin_amdgcn_fence(__ATOMIC_RELEASE, "agent");
            asm volatile("s_waitcnt vmcnt(0)" ::: "memory");
            const unsigned og = xb_add(&bar[XB_TOP], 1u);
            const unsigned tg = og / nx;
            if (og + 1u == (tg + 1u) * nx) xb_add(&bar[XB_TOPGEN], 1u);
            else XB_SPIN(xb_ld(&bar[XB_TOPGEN]) == tg, bar);
            __builtin_amdgcn_fence(__ATOMIC_ACQUIRE, "agent");
            xb_add(&bar[XB_XGEN(b.x)], 1u);
            asm volatile("s_waitcnt vmcnt(0)" ::: "memory");
        } else {
            XB_SPIN(xb_ld(&bar[XB_XGEN(b.x)]) == gen, bar);
            __builtin_amdgcn_fence(__ATOMIC_ACQUIRE, "agent");
            asm volatile("s_waitcnt vmcnt(0)" ::: "memory");
        }
    }
    __syncthreads();
}

namespace pg8 {
constexpr int BM = 256, BK = 64, HALF = 128, HTB = HALF * BK * 2, STAGE_BYTES = 8 * HTB, NXCD = 8;
#ifndef PG8_B_AUX
#define PG8_B_AUX 0
#endif
#ifndef WGM_BIGK
#define WGM_BIGK 4
#endif
#ifndef PG8_WGM
#define PG8_WGM 4
#endif
constexpr int WGM = PG8_WGM;
__host__ __device__ __forceinline__ int lds_byte(int r, int c) { const int st = (r >> 4) * 2 + (c >> 5), rr = r & 15, cc = c & 31, ob = rr * 64 + cc * 2; return st * 1024 + (ob ^ (((ob >> 9) & 1) << 5)); }
__host__ __device__ __forceinline__ void stage_rc(int b, int& R, int& C) { const int st = b / 1024, sb = b % 1024, swz = sb ^ (((sb >> 9) & 1) << 5); R = (st >> 1) * 16 + swz / 64; C = (st & 1) * 32 + (swz % 64) / 2; }
__host__ __device__ __forceinline__ int perm32(int rho) { const int n = rho >> 4, i = rho & 15; return 8 * (i >> 2) + 4 * n + (i & 3); }

__device__ __forceinline__ void glds16_s(const char* sbase, unsigned voff, unsigned lds_dst) {
    unsigned keep;
    asm volatile("s_mov_b32 %0, m0\n\ts_mov_b32 m0, %3\n\ts_nop 0\n\tglobal_load_lds_dwordx4 %1, %2\n\ts_mov_b32 m0, %0" : "=&s"(keep) : "v"(voff), "s"(sbase), "s"(lds_dst) : "memory");
}
struct Unit { const char* A; const char* B; int pm, pn, aux; };
struct GemmP { int nt; unsigned lda, ldb; };
template <int DT> struct AccOf { typedef f32x4 T; };
template <> struct AccOf<1> { typedef i32x4 T; };
__device__ __forceinline__ f32x4 tof(f32x4 v) { return v; }
__device__ __forceinline__ f32x4 tof(i32x4 v) { return __builtin_convertvector(v, f32x4); }

struct TileOrder {
    int nM, nN, nwg, G, c, wgm;
    __device__ __forceinline__ void init(int nM_, int nN_, int G_, int c_, int wgm_ = WGM) { nM = nM_; nN = nN_; nwg = nM * nN; G = G_; c = c_; wgm = wgm_; }
    __device__ __forceinline__ bool pmpn(int i, int& pm, int& pn) const {
        const long L = (long)i * G + c; if (L >= nwg) return false;
        int wgid = (int)L; { const int q = nwg / NXCD, r = nwg % NXCD, xcd = wgid % NXCD, off = wgid / NXCD; wgid = (xcd < r ? xcd * (q + 1) : r * (q + 1) + (xcd - r) * q) + off; }
        const int nig = wgm * nN, gid = wgid / nig, fm = gid * wgm, gsz = (nM - fm) < wgm ? (nM - fm) : wgm;
        pm = __builtin_amdgcn_readfirstlane(fm + ((wgid % nig) % gsz)); pn = __builtin_amdgcn_readfirstlane((wgid % nig) / gsz); return true;
    }
};

template <int DT, class Epi, class Sched, bool ALIGN_EPI>
__device__ __forceinline__ void gemm_phase(LAS unsigned char* lds, const GemmP g, const Sched& S, const Epi& E, const int wid) {
    typedef typename AccOf<DT>::T AccT;
    const int lane = lane_id(), tid = wid * 64 + lane, wr = wid >> 2, wc = wid & 3, fr = lane & 15, fq = lane >> 4;
    const int nt = g.nt;
    unsigned voffA[2], voffB[2];
#pragma unroll
    for (int i = 0; i < 2; ++i) { int R, C; stage_rc(tid * 16 + i * 8192, R, C); const int Rb = Epi::PERM ? ((R & ~31) + perm32(R & 31)) : R;
        voffA[i] = (unsigned)R * g.lda + (unsigned)C * 2u; voffB[i] = (unsigned)Rb * g.ldb + (unsigned)C * 2u; }
    const size_t kstep = (size_t)(BK * 2);
    const size_t hstepA = (size_t)HALF * g.lda, hstepB = (size_t)HALF * g.ldb;
    const unsigned ldsw = (unsigned)wid * 1024u;
    const unsigned ldsb = (unsigned)__builtin_amdgcn_readfirstlane((int)((unsigned)(uintptr_t)lds + (unsigned)wid * 1024u));
    const int aoff = lds_byte(wr * 64 + fr, fq * 8), boff = lds_byte(wc * 32 + fr, fq * 8);
#define PG8_SA(b, h) (((b) * 2 + (h)) * HTB)
#define PG8_SB(b, h) ((4 + (b) * 2 + (h)) * HTB)
#define PG8_STAGE_(bufoff, gbase, voff, AUX) do { _Pragma("unroll") for (int _i = 0; _i < 2; ++_i) { \
        if constexpr (DT == 2) glds16_s((const char*)(gbase), (voff)[_i], ldsb + (unsigned)((bufoff) + _i * 8192)); \
        else __builtin_amdgcn_global_load_lds((const unsigned*)((const char*)(gbase) + (voff)[_i]), (LAS unsigned*)(lds + (bufoff) + ldsw + _i * 8192), 16, 0, AUX); } } while (0)
#define PG8_STAGE(bufoff, gbase, voff) PG8_STAGE_(bufoff, gbase, voff, 0)
#define PG8_STAGEB(bufoff, gbase, voff) PG8_STAGE_(bufoff, gbase, voff, PG8_B_AUX)
#define PG8_LDA(dst, b, h) do { _Pragma("unroll") for (int m = 0; m < 4; ++m) _Pragma("unroll") for (int k = 0; k < 2; ++k) dst[m][k] = *(const LAS bf16x8*)(lds + PG8_SA(b, h) + aoff + m * 2048 + k * 1024); } while (0)
#define PG8_LDB(dst, b, h) do { _Pragma("unroll") for (int n = 0; n < 2; ++n) _Pragma("unroll") for (int k = 0; k < 2; ++k) dst[n][k] = *(const LAS bf16x8*)(lds + PG8_SB(b, h) + boff + n * 2048 + k * 1024); } while (0)
#define PG8_MMA(ai, bj, At, Bt) do { __builtin_amdgcn_s_setprio(1); _Pragma("unroll") for (int m = 0; m < 4; ++m) _Pragma("unroll") for (int n = 0; n < 2; ++n) { \
        if constexpr (DT == 0) { _Pragma("unroll") for (int k = 0; k < 2; ++k) acc[ai][bj][m][n] = __builtin_amdgcn_mfma_f32_16x16x32_bf16(Bt[n][k], At[m][k], acc[ai][bj][m][n], 0, 0, 0); } \
        else if constexpr (DT == 1) { _Pragma("unroll") for (int k = 0; k < 2; ++k) acc[ai][bj][m][n] = __builtin_amdgcn_mfma_i32_16x16x64_i8(__builtin_bit_cast(i32x4, Bt[n][k]), __builtin_bit_cast(i32x4, At[m][k]), acc[ai][bj][m][n], 0, 0, 0); } \
        else { const i32x4 b0_ = __builtin_bit_cast(i32x4, Bt[n][0]), b1_ = __builtin_bit_cast(i32x4, Bt[n][1]), a0_ = __builtin_bit_cast(i32x4, At[m][0]), a1_ = __builtin_bit_cast(i32x4, At[m][1]); \
            acc[ai][bj][m][n] = __builtin_amdgcn_mfma_scale_f32_16x16x128_f8f6f4((i32x8){b0_[0], b0_[1], b0_[2], b0_[3], b1_[0], b1_[1], b1_[2], b1_[3]}, (i32x8){a0_[0], a0_[1], a0_[2], a0_[3], a1_[0], a1_[1], a1_[2], a1_[3]}, acc[ai][bj][m][n], 0, 0, 0, 0, 0, 0); } } \
        __builtin_amdgcn_s_setprio(0); } while (0)
#define PG8_WAIT_V(n) asm volatile("s_waitcnt vmcnt(" #n ")" ::: "memory")
#define PG8_WAIT_L(n) asm volatile("s_waitcnt lgkmcnt(" #n ")" ::: "memory")
#define PG8_BAR __builtin_amdgcn_s_barrier()
#define PG8_SCHED __builtin_amdgcn_sched_barrier(0)
    Unit cur, nxt; int ui = 0;
    if (!S.next(0, cur)) return;
    AccT acc[2][2][4][2];
#pragma unroll
    for (int a = 0; a < 2; ++a)
#pragma unroll
        for (int b = 0; b < 2; ++b)
#pragma unroll
            for (int m = 0; m < 4; ++m)
#pragma unroll
                for (int n = 0; n < 2; ++n) acc[a][b][m][n] = (AccT){0, 0, 0, 0};
    bf16x8 At[4][2], B0[2][2], B1[2][2];
    const char* cA = cur.A; const char* cB = cur.B;
    PG8_STAGEB(PG8_SB(0, 0), cB, voffB); PG8_STAGEB(PG8_SB(0, 1), cB + hstepB, voffB); PG8_STAGE(PG8_SA(0, 0), cA, voffA); PG8_STAGE(PG8_SA(0, 1), cA + hstepA, voffA);
    if (wr == 1) PG8_BAR;
    PG8_WAIT_V(2); PG8_BAR;
    PG8_STAGEB(PG8_SB(1, 0), cB + kstep, voffB); PG8_STAGE(PG8_SA(1, 0), cA + kstep, voffA); PG8_STAGEB(PG8_SB(1, 1), cB + hstepB + kstep, voffB);
    PG8_WAIT_V(6); PG8_BAR;
    for (;;) {
        const bool has_next = S.next(ui + 1, nxt);
        const char* nA = has_next ? nxt.A : cA; const char* nB = has_next ? nxt.B : cB;
        for (int t = 0; t < nt; t += 2) {
            const bool last = (t == nt - 2);
            const char* a1 = cA + (size_t)(t + 1) * kstep;
            const char* a2 = last ? nA : cA + (size_t)(t + 2) * kstep; const char* b2 = last ? nB : cB + (size_t)(t + 2) * kstep;
            const char* a3 = a2 + kstep; const char* b3 = b2 + kstep;
            PG8_LDB(B0, 0, 0); PG8_LDB(B1, 0, 1); PG8_SCHED; PG8_LDA(At, 0, 0); PG8_STAGE(PG8_SA(1, 1), a1 + hstepA, voffA);
            PG8_WAIT_V(8); PG8_WAIT_L(0); PG8_BAR; PG8_MMA(0, 0, At, B0); PG8_MMA(0, 1, At, B1); PG8_BAR; PG8_SCHED;
            PG8_LDA(At, 0, 1); PG8_STAGEB(PG8_SB(0, 0), b2, voffB); PG8_STAGEB(PG8_SB(0, 1), b2 + hstepB, voffB); PG8_STAGE(PG8_SA(0, 0), a2, voffA);
            PG8_WAIT_V(8); PG8_WAIT_L(0); PG8_BAR; PG8_MMA(1, 0, At, B0); PG8_MMA(1, 1, At, B1); PG8_BAR; PG8_SCHED;
            PG8_LDB(B0, 1, 0); PG8_LDB(B1, 1, 1); PG8_SCHED; PG8_LDA(At, 1, 0); PG8_STAGE(PG8_SA(0, 1), a2 + hstepA, voffA);
            PG8_WAIT_V(8); PG8_WAIT_L(0); PG8_BAR; PG8_MMA(0, 0, At, B0); PG8_MMA(0, 1, At, B1); PG8_BAR; PG8_SCHED;
            PG8_LDA(At, 1, 1); PG8_STAGEB(PG8_SB(1, 0), b3, voffB); PG8_STAGEB(PG8_SB(1, 1), b3 + hstepB, voffB); PG8_STAGE(PG8_SA(1, 0), a3, voffA);
            PG8_WAIT_V(8); PG8_WAIT_L(0); PG8_BAR; PG8_MMA(1, 0, At, B0); PG8_MMA(1, 1, At, B1); PG8_BAR; PG8_SCHED;
        }
        if constexpr (ALIGN_EPI) { if (wr == 0) PG8_BAR; }
        { const int le = lane_id(); E(acc, cur, wr, wc, le & 15, le >> 4); }
        if (!has_next) break;
#pragma unroll
        for (int a = 0; a < 2; ++a)
#pragma unroll
            for (int b = 0; b < 2; ++b)
#pragma unroll
                for (int m = 0; m < 4; ++m)
#pragma unroll
                    for (int n = 0; n < 2; ++n) acc[a][b][m][n] = (AccT){0, 0, 0, 0};
        cur = nxt; cA = nA; cB = nB; ++ui;
        if constexpr (ALIGN_EPI) { if (wr == 1) PG8_BAR; }
    }
    PG8_WAIT_V(0);
    if constexpr (!ALIGN_EPI) { if (wr == 0) PG8_BAR; }
    PG8_BAR;
#undef PG8_SA
#undef PG8_SB
#undef PG8_STAGE
#undef PG8_STAGEB
#undef PG8_STAGE_
#undef PG8_LDA
#undef PG8_LDB
#undef PG8_MMA
#undef PG8_WAIT_V
#undef PG8_WAIT_L
#undef PG8_BAR
#undef PG8_SCHED
}

__device__ __forceinline__ void unpack_bf16x8(const u32x4 w, f32x4& a, f32x4& b) {
    a[0] = __uint_as_float(w.x << 16); a[1] = __uint_as_float(w.x & 0xffff0000u); a[2] = __uint_as_float(w.y << 16); a[3] = __uint_as_float(w.y & 0xffff0000u);
    b[0] = __uint_as_float(w.z << 16); b[1] = __uint_as_float(w.z & 0xffff0000u); b[2] = __uint_as_float(w.w << 16); b[3] = __uint_as_float(w.w & 0xffff0000u);
}
template <bool RES_F32> struct EpiRes {
    static constexpr bool PERM = true;
    const void* res; bf16_t* out; int ldc; const float* colscale; const float* scl;
    template <class AccT> __device__ __forceinline__ void operator()(const AccT (&acc)[2][2][4][2], const Unit& u, int wr, int wc, int fr, int fq) const {
        const int row0 = u.pm * BM + wr * 64 + fr, col0 = u.pn * BM + wc * 32 + 8 * fq;
        const float cinv = scl ? 1.0f / *scl : 1.0f;
        f32x4 cs[2][2];
#pragma unroll
        for (int bj = 0; bj < 2; ++bj)
#pragma unroll
            for (int n = 0; n < 2; ++n) cs[bj][n] = colscale ? *(const f32x4*)(colscale + col0 + bj * HALF + n * 4) * cinv : (f32x4){cinv, cinv, cinv, cinv};
#pragma unroll
        for (int ai = 0; ai < 2; ++ai)
#pragma unroll
            for (int m = 0; m < 4; ++m) { const size_t off = (size_t)(row0 + ai * HALF + m * 16) * ldc + col0;
#pragma unroll
                for (int bj = 0; bj < 2; ++bj) { f32x4 r0, r1;
                    if constexpr (RES_F32) { r0 = *(const f32x4*)((const float*)res + off + bj * HALF); r1 = *(const f32x4*)((const float*)res + off + bj * HALF + 4); }
                    else unpack_bf16x8(*(const u32x4*)((const bf16_t*)res + off + bj * HALF), r0, r1);
                    const f32x4 v0 = r0 * ALPHA + tof(acc[ai][bj][m][0]) * cs[bj][0], v1 = r1 * ALPHA + tof(acc[ai][bj][m][1]) * cs[bj][1];
                    u32x4 w; w.x = cvt_pk_bf16(v0[0], v0[1]); w.y = cvt_pk_bf16(v0[2], v0[3]); w.z = cvt_pk_bf16(v1[0], v1[1]); w.w = cvt_pk_bf16(v1[2], v1[3]);
                    *(u32x4*)(out + off + bj * HALF) = w; } }
    }
};
__device__ __forceinline__ float silu_mul(float g, float u) { return g * __builtin_amdgcn_rcpf(1.0f + __builtin_amdgcn_exp2f(-1.4426950408889634f * g)) * u; }
template <bool OUT8> struct EpiSwiGLU {
    static constexpr bool PERM = true;
    void* H; int ldh; const float* sx; const float* sw; int sw_estride;
    template <class AccT> __device__ __forceinline__ void operator()(const AccT (&acc)[2][2][4][2], const Unit& u, int wr, int wc, int fr, int fq) const {
        const int row0 = u.pm * BM + wr * 64 + fr, col0 = u.pn * HALF + wc * 32 + 8 * fq;
        const float* swp = sw + (size_t)u.aux * sw_estride + u.pn * BM + wc * 32 + 8 * fq;
        const f32x4 wg0 = *(const f32x4*)swp, wg1 = *(const f32x4*)(swp + 4), wu0 = *(const f32x4*)(swp + HALF), wu1 = *(const f32x4*)(swp + HALF + 4);
#pragma unroll
        for (int ai = 0; ai < 2; ++ai)
#pragma unroll
            for (int m = 0; m < 4; ++m) { const int r = row0 + ai * HALF + m * 16; const float sr = sx[r];
                const f32x4 g0 = tof(acc[ai][0][m][0]) * (wg0 * sr), g1 = tof(acc[ai][0][m][1]) * (wg1 * sr), u0 = tof(acc[ai][1][m][0]) * (wu0 * sr), u1 = tof(acc[ai][1][m][1]) * (wu1 * sr);
                f32x4 e0 = g0 * -1.4426950408889634f, e1 = g1 * -1.4426950408889634f;
#pragma unroll
                for (int i = 0; i < 4; ++i) { e0[i] = __builtin_amdgcn_exp2f(e0[i]); e1[i] = __builtin_amdgcn_exp2f(e1[i]); }
                e0 = e0 + 1.0f; e1 = e1 + 1.0f;
#pragma unroll
                for (int i = 0; i < 4; ++i) { e0[i] = __builtin_amdgcn_rcpf(e0[i]); e1[i] = __builtin_amdgcn_rcpf(e1[i]); }
                const f32x4 h0 = (g0 * u0) * e0, h1 = (g1 * u1) * e1;
                const float h[8] = {h0[0], h0[1], h0[2], h0[3], h1[0], h1[1], h1[2], h1[3]};
                if constexpr (OUT8) {
                    int p0 = __builtin_amdgcn_cvt_pk_fp8_f32(h[0], h[1], 0, false); p0 = __builtin_amdgcn_cvt_pk_fp8_f32(h[2], h[3], p0, true);
                    int p1 = __builtin_amdgcn_cvt_pk_fp8_f32(h[4], h[5], 0, false); p1 = __builtin_amdgcn_cvt_pk_fp8_f32(h[6], h[7], p1, true);
                    *(u32x2*)((unsigned char*)H + (size_t)r * ldh + col0) = (u32x2){(unsigned)p0, (unsigned)p1};
                } else {
                    u32x4 w; w.x = cvt_pk_bf16(h[0], h[1]); w.y = cvt_pk_bf16(h[2], h[3]); w.z = cvt_pk_bf16(h[4], h[5]); w.w = cvt_pk_bf16(h[6], h[7]);
                    *(u32x4*)((bf16_t*)H + (size_t)r * ldh + col0) = w; } }
    }
};
struct EpiBf16 {
    static constexpr bool PERM = true;
    bf16_t* O; int ldc; const float* scl;
    template <class AccT> __device__ __forceinline__ void operator()(const AccT (&acc)[2][2][4][2], const Unit& u, int wr, int wc, int fr, int fq) const {
        const int row0 = u.pm * BM + wr * 64 + fr, col0 = u.pn * BM + wc * 32 + 8 * fq;
        const float cinv = scl ? 1.0f / scl[u.aux] : 1.0f;
#pragma unroll
        for (int ai = 0; ai < 2; ++ai)
#pragma unroll
            for (int m = 0; m < 4; ++m) { bf16_t* rowp = O + (size_t)(row0 + ai * HALF + m * 16) * ldc + col0;
#pragma unroll
                for (int bj = 0; bj < 2; ++bj) { const f32x4 v0 = tof(acc[ai][bj][m][0]) * cinv, v1 = tof(acc[ai][bj][m][1]) * cinv;
                    u32x4 w; w.x = cvt_pk_bf16(v0[0], v0[1]); w.y = cvt_pk_bf16(v0[2], v0[3]); w.z = cvt_pk_bf16(v1[0], v1[1]); w.w = cvt_pk_bf16(v1[2], v1[3]);
                    *(u32x4*)(rowp + bj * HALF) = w; } }
    }
};
struct EpiQKV {
    static constexpr bool PERM = true;
    bf16_t* Q; bf16_t* Kd; bf16_t* V; const float* cs; const float* sn; const float* sx; const float* sw; unsigned* vmax;
    template <class AccT> __device__ __forceinline__ void operator()(const AccT (&acc)[2][2][4][2], const Unit& u, int wr, int wc, int fr, int fq) const {
        const int row0 = u.pm * BM + wr * 64 + fr;
        const float* swp = sw + u.pn * BM + wc * 32 + 8 * fq;
        const f32x4 w00 = *(const f32x4*)swp, w01 = *(const f32x4*)(swp + 4), w10 = *(const f32x4*)(swp + HALF), w11 = *(const f32x4*)(swp + HALF + 4);
        if (u.pn >= 16) {
            const int dcol = wc * 32 + 8 * fq;
            f32x4 vm = (f32x4){0.f, 0.f, 0.f, 0.f};
#pragma unroll
            for (int ai = 0; ai < 2; ++ai)
#pragma unroll
                for (int m = 0; m < 4; ++m) { const int r = row0 + ai * HALF + m * 16, b = r >> 12, s = r & (SEQ - 1); const float sr = sx[r];
#pragma unroll
                    for (int bj = 0; bj < 2; ++bj) { const int h = 2 * (u.pn - 16) + bj; const f32x4 v0 = tof(acc[ai][bj][m][0]) * ((bj ? w10 : w00) * sr), v1 = tof(acc[ai][bj][m][1]) * ((bj ? w11 : w01) * sr);
                        vm = __builtin_elementwise_max(vm, __builtin_elementwise_max(__builtin_elementwise_abs(v0), __builtin_elementwise_abs(v1)));
                        u32x4 w; w.x = cvt_pk_bf16(v0[0], v0[1]); w.y = cvt_pk_bf16(v0[2], v0[3]); w.z = cvt_pk_bf16(v1[0], v1[1]); w.w = cvt_pk_bf16(v1[2], v1[3]);
                        *(u32x4*)(V + ((size_t)(b * NH + h) * SEQ + s) * HD + dcol) = w; } }
            const float t = wave_max(fmaxf(fmaxf(vm[0], vm[1]), fmaxf(vm[2], vm[3])));
            if (lane_id() == 0) __hip_atomic_fetch_max(vmax, __float_as_uint(t), __ATOMIC_RELAXED, __HIP_MEMORY_SCOPE_AGENT);
        } else {
            bf16_t* dst = (u.pn >= 8) ? Kd : Q;
            const int h = 2 * (u.pn & 7) + (wc >> 1), dlo = (wc & 1) * 32 + 8 * fq;
#pragma unroll
            for (int ai = 0; ai < 2; ++ai)
#pragma unroll
                for (int m = 0; m < 4; ++m) { const int r = row0 + ai * HALF + m * 16, b = r >> 12, s = r & (SEQ - 1); const float sr = sx[r];
                    const f32x4 c0 = *(const f32x4*)(cs + s * 64 + dlo), c1 = *(const f32x4*)(cs + s * 64 + dlo + 4), s0 = *(const f32x4*)(sn + s * 64 + dlo), s1 = *(const f32x4*)(sn + s * 64 + dlo + 4);
                    const f32x4 l0 = tof(acc[ai][0][m][0]) * (w00 * sr), l1 = tof(acc[ai][0][m][1]) * (w01 * sr), h0 = tof(acc[ai][1][m][0]) * (w10 * sr), h1 = tof(acc[ai][1][m][1]) * (w11 * sr);
                    const f32x4 ol0 = l0 * c0 - h0 * s0, ol1 = l1 * c1 - h1 * s1, oh0 = h0 * c0 + l0 * s0, oh1 = h1 * c1 + l1 * s1;
                    bf16_t* p = dst + ((size_t)(b * NH + h) * SEQ + s) * HD + dlo;
                    u32x4 w; w.x = cvt_pk_bf16(ol0[0], ol0[1]); w.y = cvt_pk_bf16(ol0[2], ol0[3]); w.z = cvt_pk_bf16(ol1[0], ol1[1]); w.w = cvt_pk_bf16(ol1[2], ol1[3]);
                    *(u32x4*)p = w;
                    w.x = cvt_pk_bf16(oh0[0], oh0[1]); w.y = cvt_pk_bf16(oh0[2], oh0[3]); w.z = cvt_pk_bf16(oh1[0], oh1[1]); w.w = cvt_pk_bf16(oh1[2], oh1[3]);
                    *(u32x4*)(p + 64) = w; }
        }
    }
};
}

namespace att {
constexpr int D = 128, NW = 8, QBLK = 32, KVBLK = 64, QB = 256, LDO = DM;
constexpr float SCALE = 0.08838834764831845f;
constexpr int SHM_V = KVBLK * D * 2, SHM_K = KVBLK * D * 2;
constexpr int OFF_WS = 2 * SHM_V + 2 * SHM_K, OFF_KM = OFF_WS + NW * 64 * 4, LDS_BYTES = OFF_KM + 8192;
#define KSWZ(row, colB) ((row) * 256 + ((colB) ^ (((row) & 7) << 4)))
#define SBAR() __builtin_amdgcn_sched_barrier(0)
__device__ __forceinline__ int v_st(int k, int c) { const int kk = (k & ~0xC) | ((k & 4) << 1) | ((k & 8) >> 1); return ((kk >> 3) * 4 + (c >> 5)) * 512 + ((kk & 7) * 32 + (c & 31)) * 2; }
__device__ __forceinline__ int v_rd_base(int lane) { return ((lane & 3) << 3) | (((lane >> 2) & 3) << 6) | (((lane >> 4) & 1) << 5) | (((lane >> 5) & 1) << 8); }
constexpr int v_rd_off(int d0, int ks, int half) { return d0 * 512 + ks * 4096 + half * 2048; }
__device__ __forceinline__ int crow(int r, int hi) { return (r & 3) + 8 * (r >> 2) + 4 * hi; }
__device__ __forceinline__ bf16x8 load8(const bf16_t* p) { return *reinterpret_cast<const bf16x8*>(p); }
__device__ __forceinline__ void mask_tile(f32x16& p0, f32x16& p1, int dq) {
    const float NEG = -__builtin_inff();
#pragma unroll
    for (int r = 0; r < 16; ++r) {
        const int c = (r & 3) + 8 * (r >> 2);
        if (dq - c < 0) p0[r] = NEG;
        if (dq - c - 32 < 0) p1[r] = NEG;
    }
}
__device__ __forceinline__ void mask_all(f32x16& p0, f32x16& p1) {
    const float NEG = -__builtin_inff();
#pragma unroll
    for (int r = 0; r < 16; ++r) { p0[r] = NEG; p1[r] = NEG; }
}
constexpr float THR = 8.f;
__device__ __forceinline__ void partialSM(f32x16& p0, f32x16& p1, float& m_reg, float& mn, float& alpha, const bool rowmask) {
    float pmax = p0[0];
#pragma unroll
    for (int r = 1; r < 16; ++r) pmax = fmaxf(pmax, p0[r]);
#pragma unroll
    for (int r = 0; r < 16; ++r) pmax = fmaxf(pmax, p1[r]);
    { auto rr = __builtin_amdgcn_permlane32_swap(__float_as_uint(pmax), __float_as_uint(pmax), false, false);
      pmax = fmaxf(__uint_as_float(rr[0]), __uint_as_float(rr[1])); }
    constexpr float C2 = 1.4426950408889634f * SCALE;
    pmax = rowmask ? -__builtin_inff() : pmax;
    if (__builtin_expect(__all((pmax - m_reg) * SCALE <= THR), 1)) { mn = m_reg; alpha = 1.f; }
    else { mn = fmaxf(m_reg, pmax); alpha = __builtin_amdgcn_exp2f((m_reg - mn) * C2); m_reg = mn; }
    const float mnL = rowmask ? -__builtin_inff() : -mn * C2;
#pragma unroll
    for (int r = 0; r < 16; ++r) p0[r] = fmaf(p0[r], C2, mnL);
#pragma unroll
    for (int r = 0; r < 16; ++r) p1[r] = fmaf(p1[r], C2, mnL);
#pragma unroll
    for (int r = 0; r < 16; ++r) p0[r] = __builtin_amdgcn_exp2f(p0[r]);
}
__device__ __forceinline__ void finishSM(f32x16& p0, f32x16& p1, float alpha, float& l_reg, bf16x8& pa0, bf16x8& pa1, bf16x8& pa2, bf16x8& pa3) {
#pragma unroll
    for (int r = 0; r < 16; ++r) p1[r] = __builtin_amdgcn_exp2f(p1[r]);
    float ps = 0;
#pragma unroll
    for (int r = 0; r < 16; ++r) ps += p0[r];
#pragma unroll
    for (int r = 0; r < 16; ++r) ps += p1[r];
    { auto rr = __builtin_amdgcn_permlane32_swap(__float_as_uint(ps), __float_as_uint(ps), false, false);
      ps = __uint_as_float(rr[0]) + __uint_as_float(rr[1]); }
    l_reg = l_reg * alpha + ps;
#define PK4(P, B_, OUT) do { unsigned a0 = cvt_pk_bf16(P[B_+0], P[B_+1]), a1 = cvt_pk_bf16(P[B_+2], P[B_+3]);                          \
        unsigned b0 = cvt_pk_bf16(P[B_+4], P[B_+5]), b1 = cvt_pk_bf16(P[B_+6], P[B_+7]);                                             \
        auto r0 = __builtin_amdgcn_permlane32_swap(a0, b0, false, false); auto r1 = __builtin_amdgcn_permlane32_swap(a1, b1, false, false); \
        u32x4 w = {r0[0], r1[0], r0[1], r1[1]}; OUT = *reinterpret_cast<bf16x8*>(&w); } while (0)
    PK4(p0, 0, pa0); PK4(p0, 8, pa1); PK4(p1, 0, pa2); PK4(p1, 8, pa3);
#undef PK4
}
template <int KB>
__device__ __forceinline__ void qkt(f32x16& p0, f32x16& p1, const char* K_lds, int r32, int hi, const bf16x8* qr) {
    p0 = f32x16{}; p1 = f32x16{};
    const char* kb[4];
#pragma unroll
    for (int dd = 0; dd < 4; ++dd) kb[dd] = K_lds + KB * SHM_K + KSWZ(r32, (dd * 16 + hi * 8) * 2);
#pragma unroll
    for (int d0 = 0; d0 < 8; ++d0) { const char* a = kb[d0 & 3] + (d0 >> 2) * 128;
        bf16x8 b0 = *reinterpret_cast<const bf16x8*>(a);
        bf16x8 b1 = *reinterpret_cast<const bf16x8*>(a + 32 * 256);
        p0 = __builtin_amdgcn_mfma_f32_32x32x16_bf16(b0, qr[d0], p0, 0, 0, 0);
        p1 = __builtin_amdgcn_mfma_f32_32x32x16_bf16(b1, qr[d0], p1, 0, 0, 0); }
}
template <int VB>
__device__ __forceinline__ void pv_tile(f32x16* o, int vb0, bf16x8 pa0, bf16x8 pa1, bf16x8 pa2, bf16x8 pa3) {
#define TRRD(dst, off) asm volatile("ds_read_b64_tr_b16 %0, %1 offset:%2" : "=&v"(dst) : "v"(vb0), "i"(off) : "memory")
#define PV_RD(S_, d0) do { constexpr int b_ = VB * SHM_V + v_rd_off(d0, 0, 0); \
        TRRD(S_##l0, b_); TRRD(S_##h0, b_ + 2048); TRRD(S_##l1, b_ + 4096); TRRD(S_##h1, b_ + 6144); TRRD(S_##l2, b_ + 8192); TRRD(S_##h2, b_ + 10240); TRRD(S_##l3, b_ + 12288); TRRD(S_##h3, b_ + 14336); } while (0)
#define PV_MM(S_, d0) do { \
        o[d0] = __builtin_amdgcn_mfma_f32_32x32x16_bf16(pa0, (bf16x8){S_##l0[0], S_##l0[1], S_##l0[2], S_##l0[3], S_##h0[0], S_##h0[1], S_##h0[2], S_##h0[3]}, o[d0], 0, 0, 0);   \
        o[d0] = __builtin_amdgcn_mfma_f32_32x32x16_bf16(pa1, (bf16x8){S_##l1[0], S_##l1[1], S_##l1[2], S_##l1[3], S_##h1[0], S_##h1[1], S_##h1[2], S_##h1[3]}, o[d0], 0, 0, 0);   \
        o[d0] = __builtin_amdgcn_mfma_f32_32x32x16_bf16(pa2, (bf16x8){S_##l2[0], S_##l2[1], S_##l2[2], S_##l2[3], S_##h2[0], S_##h2[1], S_##h2[2], S_##h2[3]}, o[d0], 0, 0, 0);   \
        o[d0] = __builtin_amdgcn_mfma_f32_32x32x16_bf16(pa3, (bf16x8){S_##l3[0], S_##l3[1], S_##l3[2], S_##l3[3], S_##h3[0], S_##h3[1], S_##h3[2], S_##h3[3]}, o[d0], 0, 0, 0); } while (0)
    s16x4 Al0, Al1, Al2, Al3, Ah0, Ah1, Ah2, Ah3, Bl0, Bl1, Bl2, Bl3, Bh0, Bh1, Bh2, Bh3;
    PV_RD(A, 0);
    asm volatile("s_waitcnt lgkmcnt(0)" ::: "memory"); SBAR(); PV_RD(B, 1); SBAR(); PV_MM(A, 0); SBAR();
    asm volatile("s_waitcnt lgkmcnt(0)" ::: "memory"); SBAR(); PV_RD(A, 2); SBAR(); PV_MM(B, 1); SBAR();
    asm volatile("s_waitcnt lgkmcnt(0)" ::: "memory"); SBAR(); PV_RD(B, 3); SBAR(); PV_MM(A, 2); SBAR();
    asm volatile("s_waitcnt lgkmcnt(0)" ::: "memory"); SBAR(); PV_MM(B, 3);
#undef PV_MM
#undef PV_RD
#undef TRRD
}
template <int VB>
__device__ __forceinline__ void pv_partial(f32x16* o, int vb0, bf16x8 pa0, bf16x8 pa1, bf16x8 pa2, bf16x8 pa3, f32x16& p0, f32x16& p1, float& m_reg, float& mn, float& alpha, const bool rowmask) {
#define TRRD(dst, off) asm volatile("ds_read_b64_tr_b16 %0, %1 offset:%2" : "=&v"(dst) : "v"(vb0), "i"(off) : "memory")
#define PV_RD(S_, d0) do { constexpr int b_ = VB * SHM_V + v_rd_off(d0, 0, 0); \
        TRRD(S_##l0, b_); TRRD(S_##h0, b_ + 2048); TRRD(S_##l1, b_ + 4096); TRRD(S_##h1, b_ + 6144); TRRD(S_##l2, b_ + 8192); TRRD(S_##h2, b_ + 10240); TRRD(S_##l3, b_ + 12288); TRRD(S_##h3, b_ + 14336); } while (0)
#define PV_MM(S_, d0) do { \
        o[d0] = __builtin_amdgcn_mfma_f32_32x32x16_bf16(pa0, (bf16x8){S_##l0[0], S_##l0[1], S_##l0[2], S_##l0[3], S_##h0[0], S_##h0[1], S_##h0[2], S_##h0[3]}, o[d0], 0, 0, 0);   \
        o[d0] = __builtin_amdgcn_mfma_f32_32x32x16_bf16(pa1, (bf16x8){S_##l1[0], S_##l1[1], S_##l1[2], S_##l1[3], S_##h1[0], S_##h1[1], S_##h1[2], S_##h1[3]}, o[d0], 0, 0, 0);   \
        o[d0] = __builtin_amdgcn_mfma_f32_32x32x16_bf16(pa2, (bf16x8){S_##l2[0], S_##l2[1], S_##l2[2], S_##l2[3], S_##h2[0], S_##h2[1], S_##h2[2], S_##h2[3]}, o[d0], 0, 0, 0);   \
        o[d0] = __builtin_amdgcn_mfma_f32_32x32x16_bf16(pa3, (bf16x8){S_##l3[0], S_##l3[1], S_##l3[2], S_##l3[3], S_##h3[0], S_##h3[1], S_##h3[2], S_##h3[3]}, o[d0], 0, 0, 0); } while (0)
    s16x4 Al0, Al1, Al2, Al3, Ah0, Ah1, Ah2, Ah3, Bl0, Bl1, Bl2, Bl3, Bh0, Bh1, Bh2, Bh3;
    constexpr float C2 = 1.4426950408889634f * SCALE;
    PV_RD(A, 0);
    asm volatile("s_waitcnt lgkmcnt(0)" ::: "memory"); SBAR(); PV_RD(B, 1); SBAR();
    PV_MM(A, 0);
    float pmax = p0[0];
#pragma unroll
    for (int r = 1; r < 16; ++r) pmax = fmaxf(pmax, p0[r]);
#pragma unroll
    for (int r = 0; r < 16; ++r) pmax = fmaxf(pmax, p1[r]);
    SBAR();
    asm volatile("s_waitcnt lgkmcnt(0)" ::: "memory"); SBAR(); PV_RD(A, 2); SBAR();
    PV_MM(B, 1);
    { auto rr = __builtin_amdgcn_permlane32_swap(__float_as_uint(pmax), __float_as_uint(pmax), false, false);
      pmax = fmaxf(__uint_as_float(rr[0]), __uint_as_float(rr[1])); }
    pmax = rowmask ? -__builtin_inff() : pmax;
    if (__builtin_expect(__all((pmax - m_reg) * SCALE <= THR), 1)) { mn = m_reg; alpha = 1.f; }
    else { mn = fmaxf(m_reg, pmax); alpha = __builtin_amdgcn_exp2f((m_reg - mn) * C2); m_reg = mn; }
    const float mnL = rowmask ? -__builtin_inff() : -mn * C2;
    SBAR();
    asm volatile("s_waitcnt lgkmcnt(0)" ::: "memory"); SBAR(); PV_RD(B, 3); SBAR();
    PV_MM(A, 2);
#pragma unroll
    for (int r = 0; r < 16; ++r) p0[r] = fmaf(p0[r], C2, mnL);
#pragma unroll
    for (int r = 0; r < 16; ++r) p1[r] = fmaf(p1[r], C2, mnL);
    asm volatile("" : "+v"(p0), "+v"(p1));
    SBAR();
    asm volatile("s_waitcnt lgkmcnt(0)" ::: "memory"); SBAR();
    PV_MM(B, 3);
#pragma unroll
    for (int r = 0; r < 16; ++r) p0[r] = __builtin_amdgcn_exp2f(p0[r]);
    asm volatile("" : "+v"(p0));
#undef PV_MM
#undef PV_RD
#undef TRRD
}
struct BlockRef { int bh, qb; };
struct Seam { bf16x8 qr[8]; bf16x8 st_v0, st_v1, st_k0, st_k1; };
__device__ __forceinline__ const char* q_rows(const unsigned char* ws, const BlockRef& r) { return (const char*)(ws + WS_Q) + ((size_t)r.bh * SEQ + (size_t)r.qb * QB) * (D * 2); }
__device__ __forceinline__ const char* k_head(const unsigned char* ws, const BlockRef& r) { return (const char*)(ws + WS_K) + (size_t)r.bh * SEQ * (D * 2); }
__device__ __forceinline__ const char* v_head(const unsigned char* ws, const BlockRef& r) { return (const char*)(ws + WS_V) + (size_t)r.bh * SEQ * (D * 2); }
__device__ __forceinline__ bf16x8 ld16(const char* sbase, unsigned voff) { return *reinterpret_cast<const bf16x8*>(sbase + voff); }
#define VMW() asm volatile("s_waitcnt vmcnt(0)" ::: "memory")
#define VMWN(n) asm volatile("s_waitcnt vmcnt(%0)" :: "i"(n) : "memory")
#define SLOAD_H(Kp, Vp, k0) do { const char* vt_ = (Vp) + (size_t)(k0) * (D * 2); const char* kt_ = (Kp) + (size_t)(k0) * (D * 2); \
                         S.st_v0 = ld16(vt_, lo0); S.st_v1 = ld16(vt_, lo1); S.st_k0 = ld16(kt_, lo0); S.st_k1 = ld16(kt_, lo1); } while (0)
#define SWRITE_HK(bf) do { *(bf16x8*)(K_lds + (bf) * SHM_K + kws) = S.st_k0; *(bf16x8*)(K_lds + (bf) * SHM_K + kws + 32 * 256) = S.st_k1; } while (0)
#define SWRITE_HV(bf) do { *(bf16x8*)(V_lds + (bf) * SHM_V + vst0) = S.st_v0; *(bf16x8*)(V_lds + (bf) * SHM_V + vst1) = S.st_v1; } while (0)
#define SWRITE_H(bf) do { SWRITE_HV(bf); SWRITE_HK(bf); } while (0)
#define QLOAD(r_) do { const char* qb_ = q_rows(ws, (r_)); _Pragma("unroll") for (int d0 = 0; d0 < 8; ++d0) S.qr[d0] = ld16(qb_, qoff + d0 * 32); } while (0)
__device__ __forceinline__ void moba_prime(const unsigned char* ws, const BlockRef& cur, char* lds, Seam& S, const int wid) {
    const int lane = lane_id(), tid = wid * 64 + lane, r32 = lane & 31, hi = lane >> 5;
    const int sr = tid >> 4, sc = (tid & 15) * 8, kws = KSWZ(sr, sc * 2); char* K_lds = lds + 2 * SHM_V;
    const unsigned lo0 = (unsigned)(sr * D + sc) * 2u, lo1 = lo0 + 32u * D * 2u, qoff = (unsigned)((wid * QBLK + r32) * D + hi * 8) * 2u;
    *(u32x4*)(lds + OFF_KM + tid * 16) = (u32x4){0u, 0u, 0u, 0u};
    QLOAD(cur);
    SLOAD_H(k_head(ws, cur), v_head(ws, cur), 0); VMW(); SWRITE_HK(0);
    __syncthreads();
}
__device__ __forceinline__ void moba_block(const unsigned char* ws_, const BlockRef& cur, const BlockRef& nxt, char* lds, Seam& S, const int wid) {
    unsigned long long wsi = (unsigned long long)ws_; asm volatile("" : "+s"(wsi));
    const unsigned char* ws = (const unsigned char*)(const GAS unsigned char*)wsi;
    const int lane = lane_id(), tid = wid * 64 + lane, r32 = lane & 31, hi = lane >> 5;
    const int qb = cur.qb, NT = 4 * (qb + 1);
    const int qlo = wid * QBLK, qm = qlo + r32 - 4 * hi;
    char* V_lds = lds; char* K_lds = lds + 2 * SHM_V;
    float* wsf = (float*)(lds + OFF_WS) + wid * 64; float* li_l = wsf, * al_l = wsf + 32;
    float m_reg = -1e30f, l_reg = 0; f32x16 o[4] = {};
    const int sr = tid >> 4, sc = (tid & 15) * 8, vst0 = v_st(sr, sc), vst1 = v_st(32 + sr, sc), kws = KSWZ(sr, sc * 2);
    const unsigned lo0 = (unsigned)(sr * D + sc) * 2u, lo1 = lo0 + 32u * D * 2u, qoff = (unsigned)((wid * QBLK + r32) * D + hi * 8) * 2u;
    const int vb0 = (int)(uintptr_t)V_lds + v_rd_base(lane);
    const char* Kh = k_head(ws, cur); const char* Vh = v_head(ws, cur);
    unsigned sel = 0u;
    if (qb > 0) {
        if (tid < 256) { const int row = tid >> 4, ch = tid & 15; *(bf16x8*)(lds + OFF_KM + KSWZ(row, ch * 16)) = ld16((const char*)(ws + WS_KMEAN) + (size_t)cur.bh * NBLK * (D * 2), (unsigned)(row * D + ch * 8) * 2u); }
        __syncthreads();
        f32x16 g = f32x16{};
        { const char* kmb[4];
#pragma unroll
          for (int dd = 0; dd < 4; ++dd) kmb[dd] = lds + OFF_KM + KSWZ(r32, (dd * 16 + hi * 8) * 2);
#pragma unroll
          for (int d0 = 0; d0 < 8; ++d0) { const bf16x8 b0 = *reinterpret_cast<const bf16x8*>(kmb[d0 & 3] + (d0 >> 2) * 128); g = __builtin_amdgcn_mfma_f32_32x32x16_bf16(b0, S.qr[d0], g, 0, 0, 0); } }
        float gv[16];
#pragma unroll
        for (int r = 0; r < 8; ++r) { const float mine = g[r], oth = __shfl_xor(mine, 32); const int kb_ = (r & 3) + 8 * (r >> 2);
            gv[kb_] = hi ? oth : mine; gv[kb_ + 4] = hi ? mine : oth; }
        const float NEGI = -__builtin_inff();
#pragma unroll
        for (int n = 0; n < 16; ++n) if (n >= qb) gv[n] = NEGI;
#pragma unroll
        for (int k = 0; k < 3; ++k) { float best = NEGI; int bi = -1;
#pragma unroll
            for (int n = 0; n < 16; ++n) { const bool ok = (((sel >> n) & 1u) == 0u) && (gv[n] > best); best = ok ? gv[n] : best; bi = ok ? n : bi; }
            if (bi >= 0) sel |= 1u << bi; }
    }
#define RESC(a) do { if (__any((a) < 1.f)) { if (hi == 0) al_l[r32] = (a); asm volatile("s_waitcnt lgkmcnt(0)" ::: "memory");              \
                     _Pragma("unroll") for (int d_ = 0; d_ < 4; ++d_) _Pragma("unroll") for (int r = 0; r < 16; ++r) o[d_][r] *= al_l[crow(r, hi)]; } } while (0)
#define KBASE(t) ((t) * KVBLK)
#define MASKT(P0_, P1_, t, RM_) do { const int jb_ = (t) >> 2; RM_ = (jb_ != qb) && (((sel >> jb_) & 1u) == 0u);                                          \
                                if (jb_ == qb) { const int kb_ = ((t) & 3) * KVBLK; if (kb_ + KVBLK - 1 > qlo) mask_tile(P0_, P1_, qm - kb_); } } while (0)
    constexpr int NQL = 8;
#define SEAM_K0() do { VMWN(NQL); SWRITE_HK(0); SBAR(); } while (0)
    f32x16 pA0, pA1, pB0, pB1; float mnA, mnB, alA, alB; bf16x8 pa0, pa1, pa2, pa3;
    SWRITE_HV(0); SBAR();
    if (NT > 1) { SLOAD_H(Kh, Vh, KBASE(1)); }
    SBAR(); qkt<0>(pA0, pA1, K_lds, r32, hi, S.qr);
    { bool rm_; MASKT(pA0, pA1, 0, rm_); partialSM(pA0, pA1, m_reg, mnA, alA, rm_); }
    if (NT > 1) { VMW(); SWRITE_H(1); }
    __syncthreads();
#define HALF_STEP(PX0, PX1, mnX, alX, PY0, PY1, alY, t, KB, VB, SB) do {                                                      \
        SBAR(); if ((t) + 1 < NT) { SLOAD_H(Kh, Vh, KBASE((t) + 1)); SBAR(); }                                               \
        qkt<KB>(PX0, PX1, K_lds, r32, hi, S.qr);                                             \
        finishSM(PY0, PY1, alY, l_reg, pa0, pa1, pa2, pa3); SBAR();                                                           \
        { bool rm_; MASKT(PX0, PX1, (t), rm_); pv_partial<VB>(o, vb0, pa0, pa1, pa2, pa3, PX0, PX1, m_reg, mnX, alX, rm_); }                                                               \
        __syncthreads();                                                                                                      \
        if ((t) + 1 < NT) { VMW(); SWRITE_H(SB); }                                                                          \
        RESC(alX); __syncthreads(); } while (0)
    for (int t = 1; t + 1 < NT; t += 2) {
        HALF_STEP(pB0, pB1, mnB, alB, pA0, pA1, alA, t, 1, 0, 0);
        HALF_STEP(pA0, pA1, mnA, alA, pB0, pB1, alB, t + 1, 0, 1, 1);
    }
    const bool even = (NT & 1) == 0;
    if (even) { SBAR(); qkt<1>(pB0, pB1, K_lds, r32, hi, S.qr); SBAR(); }
    SLOAD_H(k_head(ws, nxt), v_head(ws, nxt), 0); SBAR();
    QLOAD(nxt);
    SBAR();
    finishSM(pA0, pA1, alA, l_reg, pa0, pa1, pa2, pa3); SBAR();
    pv_tile<0>(o, vb0, pa0, pa1, pa2, pa3);
    if (even) { { bool rm_; MASKT(pB0, pB1, NT - 1, rm_); partialSM(pB0, pB1, m_reg, mnB, alB, rm_); } __syncthreads(); RESC(alB);
        finishSM(pB0, pB1, alB, l_reg, pa0, pa1, pa2, pa3); SBAR(); pv_tile<1>(o, vb0, pa0, pa1, pa2, pa3); }
    SBAR(); SEAM_K0();
    if (hi == 0) li_l[r32] = l_reg; asm volatile("s_waitcnt lgkmcnt(0)" ::: "memory");
    float rli[16];
#pragma unroll
    for (int r = 0; r < 16; ++r) rli[r] = __builtin_amdgcn_rcpf(li_l[crow(r, hi)]);
    { const int b = cur.bh / NH, h = cur.bh % NH;
      int r32e = r32, hie = hi; asm volatile("" : "+v"(r32e), "+v"(hie));
      const float so = ((const float*)(ws + WS_SCL))[NE + 2];
      char* Ob = (char*)(ws + WS_O) + (((size_t)b * SEQ + (size_t)qb * QB + (size_t)(wid * QBLK)) * LDO + (size_t)h * D);
      const unsigned obase = (unsigned)(4 * hie * LDO + r32e);
#pragma unroll
      for (int r = 0; r < 16; ++r) { const unsigned ooff = obase + (unsigned)(((r & 3) + 8 * (r >> 2)) * LDO); const float sc_ = rli[r] * so;
#pragma unroll
        for (int d0 = 0; d0 < 4; ++d0) { const float v = o[d0][r] * sc_;
            const float v1 = quad_xor1(v), v2 = quad_xor2(v), v3 = quad_xor2(v1);
            int pk = __builtin_amdgcn_cvt_pk_fp8_f32(v, v1, 0, false); pk = __builtin_amdgcn_cvt_pk_fp8_f32(v2, v3, pk, true);
            if ((r32e & 3) == 0) *(unsigned*)(Ob + ooff + d0 * 32) = (unsigned)pk; } } }
    __syncthreads();
#undef RESC
#undef KBASE
#undef MASKT
#undef SEAM_K0
#undef HALF_STEP
}
#undef VMW
#undef VMWN
#undef SLOAD_H
#undef SWRITE_HK
#undef SWRITE_HV
#undef SWRITE_H
#undef QLOAD
__device__ __forceinline__ BlockRef block_ref(int item, int pass) { BlockRef r; r.bh = item >> 3; const int y = item & 7; r.qb = pass ? (NBLK - 1 - y) : y; return r; }
template <class Side> __device__ __forceinline__ void attn_phase(char* lds, const unsigned char* ws, int G, int vcu, const int wid, const Side& side) {
    constexpr int NITEMS = NB * NH * (NBLK / 2);
    const int ipc = (NITEMS + G - 1) / G, first = vcu * ipc; int last = first + ipc; if (last > NITEMS) last = NITEMS;
    if (first >= last) { side(0, 1); return; }
    const int nblk = 2 * (last - first);
    side(0, nblk + 1);
    BlockRef cur = block_ref(first, 0);
    Seam S;
    moba_prime(ws, cur, lds, S, wid);
    for (int k = 0; k < nblk; ++k) {
        const int kn = (k + 1 < nblk) ? k + 1 : k;
        const BlockRef nxt = block_ref(first + (kn >> 1), kn & 1);
        moba_block(ws, cur, nxt, lds, S, wid);
        side(k + 1, nblk + 1);
        cur = nxt;
    }
}
#undef KSWZ
#undef SBAR
}

struct Frame {
    LAS unsigned char* lds;
    volatile LAS unsigned* MISC;
    unsigned* ctl;
    int wave, vcu, G;
    unsigned char* ws;
    __device__ __forceinline__ const float* in(int k) const { const volatile LAS unsigned* p = MISC + 64 + 2 * k; const unsigned lo = __builtin_amdgcn_readfirstlane((int)p[0]), hi = __builtin_amdgcn_readfirstlane((int)p[1]);
        return (const float*)(const GAS float*)(((unsigned long long)hi << 32) | lo); }
    float* out;
};
enum { I_X = 0, I_POOLW, I_POOLS, I_WKV, I_WQ, I_WO, I_FG, I_FU, I_FD, I_MR, I_MG, I_MU, I_MD, I_LMG, I_LMB, I_LFG, I_LFB };

template <int MODE> __device__ __forceinline__ int rowmap(int n) {
    if (MODE == 0) return n;
    if (MODE == 1) return (n >> 7) * 256 + (n & 127);
    if (MODE == 2) return (n >> 7) * 256 + 128 + (n & 127);
    const int h = n >> 7, d = n & 127;
    return (h >> 1) * 256 + (d >> 6) * 128 + (h & 1) * 64 + (d & 63);
}
template <int MODE> __device__ __forceinline__ void transpose_item(const float* W, int K, int N, int ldw, bf16_t* WT, LAS float* scr, int item, int lane) {
    const int nblk = N / 32, kb = item / nblk, nb = item % nblk, k0 = 64 * kb, n0 = 32 * nb;
#pragma unroll 8
    for (int i = 0; i < 32; ++i) { const int kk = 2 * i + (lane >> 5); scr[kk * 33 + (lane & 31)] = W[(size_t)(k0 + kk) * ldw + n0 + (lane & 31)]; }
    LDS_WAIT(); asm volatile("" ::: "memory");
    const int c = lane & 7;
#pragma unroll
    for (int j = 0; j < 4; ++j) { const int n = (lane >> 3) + 8 * j; const LAS float* s = scr + (8 * c) * 33 + n;
        u32x4 o; o.x = cvt_pk_bf16(s[0 * 33], s[1 * 33]); o.y = cvt_pk_bf16(s[2 * 33], s[3 * 33]); o.z = cvt_pk_bf16(s[4 * 33], s[5 * 33]); o.w = cvt_pk_bf16(s[6 * 33], s[7 * 33]);
        *(u32x4*)(WT + (size_t)rowmap<MODE>(n0 + n) * K + k0 + 8 * c) = o; }
    LDS_WAIT(); asm volatile("" ::: "memory");
}
__device__ __forceinline__ void convert_family(Frame& F, const float* W, int K, int N, size_t src_stride, bf16_t* WT, size_t dst_stride, int nmat) {
    const int lane_ = lane_id(), tid_ = F.wave * 64 + lane_; (void)tid_;
    constexpr int PITCH = 528;
    LAS unsigned char* tile = F.lds + RING_OFF;
    const int KT = K / 256, NT_ = N / 64, per = KT * NT_, total = per * nmat;
    const int cg = lane_ & 15, slot = F.wave * 4 + (lane_ >> 4);
    for (int it = F.vcu; it < total; it += F.G) { const int mi = it / per, r = it - mi * per, kt = r / NT_, nt = r - kt * NT_;
        const float* src = W + (size_t)mi * src_stride + ((size_t)kt * 256 + slot * 8) * N + nt * 64 + 4 * cg;
        f32x4 v[8];
#pragma unroll
        for (int i = 0; i < 8; ++i) v[i] = *(const f32x4*)(src + (size_t)i * N);
#pragma unroll
        for (int c = 0; c < 4; ++c) { u32x4 o; o.x = cvt_pk_bf16(v[0][c], v[1][c]); o.y = cvt_pk_bf16(v[2][c], v[3][c]); o.z = cvt_pk_bf16(v[4][c], v[5][c]); o.w = cvt_pk_bf16(v[6][c], v[7][c]);
            *(LAS u32x4*)(tile + (4 * cg + c) * PITCH + slot * 16) = o; }
        __syncthreads();
        bf16_t* dst = WT + (size_t)mi * dst_stride;
#pragma unroll
        for (int p = 0; p < 4; ++p) { const int n = p * 16 + (tid_ >> 5), kb = (tid_ & 31) * 16;
            *(u32x4*)((unsigned char*)(dst + (size_t)(nt * 64 + n) * K + kt * 256) + kb) = *(const LAS u32x4*)(tile + n * PITCH + kb); }
        __syncthreads(); }
}
__device__ __forceinline__ int rowmap_rt(int mode, int n) { return mode == 0 ? rowmap<0>(n) : mode == 1 ? rowmap<1>(n) : mode == 2 ? rowmap<2>(n) : rowmap<3>(n); }
struct StripDesc { const float* W; int ldw, n0, mode; i8_t* WT; float* SW; };
constexpr int NS_M = NE * 2 * (DFE / 32), NS_F = 2 * (DFF / 32), NS_Q = 3 * (DM / 32);
__device__ __forceinline__ void strip_load(f32x4 (&v)[32], const StripDesc& d, int cg, int slot) {
    const float* src = d.W + (size_t)(slot * 32) * d.ldw + d.n0 + 4 * cg;
#pragma unroll
    for (int i = 0; i < 32; ++i) v[i] = __builtin_nontemporal_load((const f32x4*)(src + (size_t)i * d.ldw));
}
template <class Item> __device__ __forceinline__ void quant_strips(Frame& F, LAS unsigned char* tile, int j0, int j1, const Item& item) {
    const int lane_ = lane_id(), tid_ = F.wave * 64 + lane_;
    LAS float* red = (LAS float*)(tile + 32 * 2064);
    const int cg = lane_ & 7, slot = F.wave * 8 + (lane_ >> 3);
    f32x4 v[32]; StripDesc cur, nx;
    bool have = (j0 < j1) && item(j0, cur);
    if (have) strip_load(v, cur, cg, slot);
    for (int j = j0; have; ++j) {
        f32x4 mx = (f32x4){0.f, 0.f, 0.f, 0.f};
#pragma unroll
        for (int i = 0; i < 32; ++i) mx = __builtin_elementwise_max(mx, __builtin_elementwise_abs(v[i]));
#pragma unroll
        for (int c = 0; c < 4; ++c) { float t = mx[c]; t = fmaxf(t, __shfl_xor(t, 8)); t = fmaxf(t, __shfl_xor(t, 16)); t = fmaxf(t, __shfl_xor(t, 32)); mx[c] = t; }
        if ((lane_ >> 3) == 0) *(LAS f32x4*)(red + F.wave * 32 + 4 * cg) = mx;
        __syncthreads();
        f32x4 cm = *(const LAS f32x4*)(red + 4 * cg);
#pragma unroll
        for (int w = 1; w < 8; ++w) cm = __builtin_elementwise_max(cm, *(const LAS f32x4*)(red + w * 32 + 4 * cg));
        f32x4 inv, sc;
#pragma unroll
        for (int c = 0; c < 4; ++c) { sc[c] = cm[c] > 0.f ? cm[c] * (1.f / 127.f) : 1.f; inv[c] = cm[c] > 0.f ? 127.f / cm[c] : 0.f; }
        const bool hn = (j + 1 < j1) && item(j + 1, nx);
        const float* nsrc = hn ? nx.W + (size_t)(slot * 32) * nx.ldw + nx.n0 + 4 * cg : nullptr; const size_t nld = hn ? (size_t)nx.ldw : 0;
#pragma unroll
        for (int p8 = 0; p8 < 4; ++p8) {
#pragma unroll
            for (int c = 0; c < 4; ++c) { u32x2 d;
                d.x = pack_i8x4(v[8 * p8][c] * inv[c], v[8 * p8 + 1][c] * inv[c], v[8 * p8 + 2][c] * inv[c], v[8 * p8 + 3][c] * inv[c]);
                d.y = pack_i8x4(v[8 * p8 + 4][c] * inv[c], v[8 * p8 + 5][c] * inv[c], v[8 * p8 + 6][c] * inv[c], v[8 * p8 + 7][c] * inv[c]);
                *(LAS u32x2*)(tile + (4 * cg + c) * 2064 + slot * 32 + 8 * p8) = d; }
            asm volatile("" ::: "memory");
            if (hn) {
#pragma unroll
                for (int i = 8 * p8; i < 8 * p8 + 8; ++i) v[i] = __builtin_nontemporal_load((const f32x4*)(nsrc + (size_t)i * nld)); }
            asm volatile("" ::: "memory");
        }
        if (slot == 0) {
#pragma unroll
            for (int c = 0; c < 4; ++c) cur.SW[rowmap_rt(cur.mode, cur.n0 + 4 * cg + c)] = sc[c]; }
        __syncthreads();
#pragma unroll
        for (int it = 0; it < 8; ++it) { const int n = it * 4 + (tid_ >> 7), kb = (tid_ & 127) * 16;
            __builtin_nontemporal_store(*(const LAS u32x4*)(tile + n * 2064 + kb), (u32x4*)(cur.WT + (size_t)rowmap_rt(cur.mode, cur.n0 + n) * 2048 + kb)); }
        __syncthreads();
        cur = nx; have = hn;
    }
}
struct MoeStripItem { Frame& F;
    __device__ __forceinline__ bool operator()(int j, StripDesc& d) const { const int st = F.vcu + F.G * j; if (st >= NS_M) return false;
        const int e = st / (2 * (DFE / 32)), r = st % (2 * (DFE / 32)), up = r >= DFE / 32 ? 1 : 0;
        d.W = (up ? F.in(I_MU) : F.in(I_MG)) + (size_t)e * DM * DFE; d.ldw = DFE; d.n0 = 32 * (r - up * (DFE / 32)); d.mode = 1 + up;
        d.WT = (i8_t*)(F.ws + WS_MWGU) + (size_t)e * 2 * DFE * DM; d.SW = (float*)(F.ws + WS_SWM) + (size_t)e * 2 * DFE; return true; } };
struct DenseStripItem { Frame& F;
    __device__ __forceinline__ bool operator()(int j, StripDesc& d) const { const int st = F.vcu + F.G * j; if (st >= NS_F + NS_Q) return false;
        if (st < NS_F) { const int up = st >= DFF / 32 ? 1 : 0; d.W = up ? F.in(I_FU) : F.in(I_FG); d.ldw = DFF; d.n0 = 32 * (st - up * (DFF / 32)); d.mode = 1 + up;
            d.WT = (i8_t*)(F.ws + WS_WGU); d.SW = (float*)(F.ws + WS_SWGU); }
        else { const int r = st - NS_F, which = r / (DM / 32); d.W = which == 0 ? F.in(I_WQ) : (which == 1 ? F.in(I_WKV) : F.in(I_WKV) + DM); d.ldw = which == 0 ? DM : 2 * DM;
            d.n0 = 32 * (r % (DM / 32)); d.mode = which == 2 ? 0 : 3; d.WT = (i8_t*)(F.ws + WS_WQKV) + (size_t)which * DM * DM; d.SW = (float*)(F.ws + WS_SWQKV) + which * DM; }
        return true; } };
__device__ __forceinline__ void quant_weights(Frame& F) { quant_strips(F, F.lds + RING_OFF, 0, (NS_F + NS_Q + F.G - 1) / F.G, DenseStripItem{F}); }
__device__ __forceinline__ void down_scale_sample(Frame& F) {
    const int lane_ = lane_id(), tid_ = F.wave * 64 + lane_;
    LAS float* red = (LAS float*)(F.lds + RING_OFF);
    if (F.vcu < NE + 2) { const int w = F.vcu; const int K = w < NE ? DFE : (w == NE ? DFF : DM); const float* W = w < NE ? F.in(I_MD) + (size_t)w * DFE * DM : (w == NE ? F.in(I_FD) : F.in(I_WO));
        f32x4 mx = (f32x4){0.f, 0.f, 0.f, 0.f};
#pragma unroll 8
        for (int i = 0; i < 32; ++i) mx = __builtin_elementwise_max(mx, __builtin_elementwise_abs(*(const f32x4*)(W + (size_t)i * (K / 32) * DM + 4 * tid_)));
        const float m = wave_max(fmaxf(fmaxf(mx[0], mx[1]), fmaxf(mx[2], mx[3])));
        if (lane_ == 0) red[F.wave] = m;
        __syncthreads();
        if (tid_ == 0) { float t = red[0]; for (int i = 1; i < NWAVES; ++i) t = fmaxf(t, red[i]);
            const unsigned eb = (__float_as_uint(t) >> 23) & 0xffu;
            ((float*)(F.ws + WS_SCL))[w] = (eb < 5u || eb > 250u) ? 1.0f : __uint_as_float((258u - eb) << 23); }
        __syncthreads();
    }
}
__device__ __forceinline__ void down_quant(Frame& F, LAS unsigned char* tile, const float* W, int K, int nmat, const float* scl, unsigned char* WT, int j0, int j1) {
    const int lane_ = lane_id(), tid_ = F.wave * 64 + lane_;
    constexpr int NT_ = DM / 64, TK = 512, RPT = TK / 32, PITCH = TK + 16;
    const int KT = K / TK, PER = KT * NT_, TOTAL = PER * nmat;
    const int cg = lane_ & 15, slot = F.wave * 4 + (lane_ >> 4);
    f32x4 v[RPT], nv[RPT];
    bool have = j0 < j1 && F.vcu + F.G * j0 < TOTAL;
    if (have) { const int it = F.vcu + F.G * j0, e = it / PER, r = it % PER, kt = r / NT_, nt = r % NT_; const float* src = W + ((size_t)e * K + (size_t)kt * TK + slot * RPT) * DM + nt * 64 + 4 * cg;
#pragma unroll
        for (int i = 0; i < RPT; ++i) nv[i] = __builtin_nontemporal_load((const f32x4*)(src + (size_t)i * DM)); }
    for (int j = j0; have; ++j) { const int it = F.vcu + F.G * j;
        const int e = it / PER, r = it % PER, kt = r / NT_, nt = r % NT_;
#pragma unroll
        for (int i = 0; i < RPT; ++i) v[i] = nv[i];
        const int itn = it + F.G; const bool hn = (j + 1 < j1) && itn < TOTAL;
        if (hn) { const int e2 = itn / PER, r2 = itn % PER, kt2 = r2 / NT_, nt2 = r2 % NT_; const float* src = W + ((size_t)e2 * K + (size_t)kt2 * TK + slot * RPT) * DM + nt2 * 64 + 4 * cg;
#pragma unroll
            for (int i = 0; i < RPT; ++i) nv[i] = __builtin_nontemporal_load((const f32x4*)(src + (size_t)i * DM)); }
        const float sc_ = __uint_as_float((unsigned)__builtin_amdgcn_readfirstlane((int)__float_as_uint(scl[e])));
#define Q8(x) fminf(fmaxf((x) * sc_, -448.f), 448.f)
#pragma unroll
        for (int c = 0; c < 4; ++c) { u32x4 d;
#pragma unroll
            for (int q = 0; q < 4; ++q) { int p0 = __builtin_amdgcn_cvt_pk_fp8_f32(Q8(v[4 * q][c]), Q8(v[4 * q + 1][c]), 0, false); p0 = __builtin_amdgcn_cvt_pk_fp8_f32(Q8(v[4 * q + 2][c]), Q8(v[4 * q + 3][c]), p0, true); d[q] = (unsigned)p0; }
            *(LAS u32x4*)(tile + (4 * cg + c) * PITCH + slot * RPT) = d; }
#undef Q8
        __syncthreads();
#pragma unroll
        for (int p = 0; p < 4; ++p) { const int n = p * 16 + (tid_ >> 5), kb = (tid_ & 31) * 16;
            __builtin_nontemporal_store(*(const LAS u32x4*)(tile + n * PITCH + kb), (u32x4*)(WT + ((size_t)e * DM + nt * 64 + n) * K + kt * TK + kb)); }
        __syncthreads();
        have = hn;
    }
}
__device__ __forceinline__ void moe_side_work(Frame& F, int slot, int nslots) {
    if (slot != (F.vcu >> 3) % nslots) return;
    LAS unsigned char* tile = F.lds + SIDE_OFF;
    quant_strips(F, tile, 0, (NS_M + F.G - 1) / F.G, MoeStripItem{F});
    down_quant(F, tile, F.in(I_MD), DFE, NE, (const float*)(F.ws + WS_SCL), F.ws + WS_MWD, 0, (NE * (DFE / 512) * (DM / 64) + F.G - 1) / F.G);
}
__device__ __forceinline__ void rope_tables(Frame& F) {
    const int lane_ = lane_id(), tid_ = F.wave * 64 + lane_; (void)tid_;
    float* cs = (float*)(F.ws + WS_COS); float* sn = (float*)(F.ws + WS_SIN);
    const int gt = F.vcu * NTHREADS + tid_, NGT = F.G * NTHREADS;
    for (int e = gt; e < SEQ * 64; e += NGT) { const int pos = e >> 6, i = e & 63;
        const float inv = 1.0f / __builtin_exp2f((float)i * (13.287712379549449f / 64.0f));
        const float angf = (float)pos * inv;
        const double turns = (double)angf * 0.15915494309189535; const double fr = turns - __builtin_floor(turns);
        const float frf = (float)fr;
        cs[e] = __builtin_amdgcn_cosf(frf); sn[e] = __builtin_amdgcn_sinf(frf); }
}
__device__ __forceinline__ void pool_diff(Frame& F) {
    const int lane_ = lane_id(), tid_ = F.wave * 64 + lane_; (void)tid_;
    bf16_t* diff = (bf16_t*)(F.ws + WS_DIFF); const float* x = F.in(I_X);
    const int gw = F.vcu * NWAVES + F.wave, NGW = F.G * NWAVES;
    for (int it = gw; it < (M / 32) * 8; it += NGW) { const int j = it & 7, r0 = (it >> 3) * 32, s0 = r0 & (SEQ - 1), w = 2 << (j >> 1);
        const float* xp = x + (size_t)r0 * DM + 256 * j + 4 * lane_; bf16_t* dp = diff + (size_t)r0 * DM + 256 * j + 4 * lane_;
        f32x4 sum = (f32x4){0.f, 0.f, 0.f, 0.f};
        const int have = (s0 + 1 < w) ? s0 + 1 : w;
        for (int i = 1; i < have; ++i) sum += *(const f32x4*)(xp - (size_t)i * DM);
#pragma unroll
        for (int rr = 0; rr < 32; ++rr) { const int s = s0 + rr; const f32x4 x0 = *(const f32x4*)(xp + (size_t)rr * DM); sum += x0;
            const int cnt = (s + 1 < w) ? s + 1 : w; const float ic = 1.0f / (float)cnt; const f32x4 d = sum * ic - x0;
            u32x2 o; o.x = cvt_pk_bf16(d[0], d[1]); o.y = cvt_pk_bf16(d[2], d[3]); *(u32x2*)(dp + (size_t)rr * DM) = o;
            if (s + 1 >= w) sum -= *(const f32x4*)(xp + (size_t)(rr - (w - 1)) * DM); } }
}
__device__ __forceinline__ void ln_inplace(f32x4 (&v)[8], const float* g, const float* b, int lane) {
    float s = 0.f;
#pragma unroll
    for (int j = 0; j < 8; ++j) s += (v[j][0] + v[j][1]) + (v[j][2] + v[j][3]);
    const float mean = wave_sum(s) * (1.f / DM); float s2 = 0.f;
#pragma unroll
    for (int j = 0; j < 8; ++j) { v[j] = v[j] - mean; s2 += (v[j][0] * v[j][0] + v[j][1] * v[j][1]) + (v[j][2] * v[j][2] + v[j][3] * v[j][3]); }
    const float rstd = 1.f / sqrtf(wave_sum(s2) * (1.f / DM) + LN_EPS);
#pragma unroll
    for (int j = 0; j < 8; ++j) { const f32x4 gg = *(const f32x4*)(g + 256 * j + 4 * lane), bb = *(const f32x4*)(b + 256 * j + 4 * lane); v[j] = v[j] * rstd * gg + bb; }
}
__device__ __forceinline__ f32x4 bf16x4_to_f32(const u32x2 w) { f32x4 r; r[0] = __uint_as_float(w.x << 16); r[1] = __uint_as_float(w.x & 0xffff0000u); r[2] = __uint_as_float(w.y << 16); r[3] = __uint_as_float(w.y & 0xffff0000u); return r; }
__device__ __forceinline__ f32x4 ld_bf16x4(const bf16_t* p) { const u32x2 w = *(const u32x2*)p; f32x4 r; r[0] = __uint_as_float(w.x << 16); r[1] = __uint_as_float(w.x & 0xffff0000u); r[2] = __uint_as_float(w.y << 16); r[3] = __uint_as_float(w.y & 0xffff0000u); return r; }
__device__ __forceinline__ void store_row_f32_q(const f32x4 (&v)[8], bf16_t* xf, i8_t* xq, float* sxp, int lane) {
    float am = 0.f;
#pragma unroll
    for (int j = 0; j < 8; ++j) am = fmaxf(fmaxf(am, fmaxf(fabsf(v[j][0]), fabsf(v[j][1]))), fmaxf(fabsf(v[j][2]), fabsf(v[j][3])));
    am = wave_max(am);
    const float sc = am > 0.f ? am * (1.f / 127.f) : 1.f, inv = am > 0.f ? 127.f / am : 0.f;
#pragma unroll
    for (int j = 0; j < 8; ++j) { u32x2 o; o.x = cvt_pk_bf16(v[j][0], v[j][1]); o.y = cvt_pk_bf16(v[j][2], v[j][3]); *(u32x2*)(xf + 256 * j + 4 * lane) = o; *(unsigned*)(xq + 256 * j + 4 * lane) = pack_i8x4(v[j][0] * inv, v[j][1] * inv, v[j][2] * inv, v[j][3] * inv); }
    if (lane == 0) *sxp = sc;
}
__device__ __forceinline__ void ln_phase(Frame& F, const bf16_t* u, const float* g, const float* b) {
    const int lane_ = lane_id(), tid_ = F.wave * 64 + lane_; (void)tid_;
    bf16_t* XF = (bf16_t*)(F.ws + WS_XF); i8_t* XQ = (i8_t*)(F.ws + WS_XB); float* SX = (float*)(F.ws + WS_SX);
    const int gw = F.vcu * NWAVES + F.wave, NGW = F.G * NWAVES;
    u32x2 nw[8];
    if (gw < M) {
#pragma unroll
        for (int j = 0; j < 8; ++j) nw[j] = *(const u32x2*)(u + (size_t)gw * DM + 256 * j + 4 * lane_); }
    for (int m = gw; m < M; m += NGW) { f32x4 v[8];
#pragma unroll
        for (int j = 0; j < 8; ++j) v[j] = bf16x4_to_f32(nw[j]);
        { const int mn = (m + NGW < M) ? m + NGW : m;
#pragma unroll
          for (int j = 0; j < 8; ++j) nw[j] = *(const u32x2*)(u + (size_t)mn * DM + 256 * j + 4 * lane_); }
        ln_inplace(v, g, b, lane_);
        store_row_f32_q(v, XF + (size_t)m * DM, XQ + (size_t)m * DM, SX + m, lane_); }
}
__device__ __forceinline__ void ln_router_phase(Frame& F, const bf16_t* u, const float* g, const float* b) {
    const int lane_ = lane_id(), tid_ = F.wave * 64 + lane_; (void)tid_;
    bf16_t* XF = (bf16_t*)(F.ws + WS_XF); i8_t* XQ = (i8_t*)(F.ws + WS_XB); float* SX = (float*)(F.ws + WS_SX);
    int* tokE = (int*)(F.ws + WS_TOKE); float* tokG = (float*)(F.ws + WS_TOKG); int* tokR = (int*)(F.ws + WS_TOKR);
    LAS float* wr = (LAS float*)(F.lds + RING_OFF);
    LAS int* lcnt = (LAS int*)(F.lds + RING_OFF + 65536);
    for (int i = tid_; i < DM * NE / 4; i += NTHREADS) ((LAS f32x4*)wr)[i] = ((const f32x4*)F.in(I_MR))[i];
    if (tid_ < 16) lcnt[tid_] = 0;
    __syncthreads();
    const int rows_per_wg = (M + F.G - 1) / F.G, m0 = F.vcu * rows_per_wg; int m1 = m0 + rows_per_wg; if (m1 > M) m1 = M;
    u32x2 nw[8];
    if (m0 + F.wave < m1) {
#pragma unroll
        for (int j = 0; j < 8; ++j) nw[j] = *(const u32x2*)(u + (size_t)(m0 + F.wave) * DM + 256 * j + 4 * lane_); }
    for (int m = m0 + F.wave; m < m1; m += NWAVES) { f32x4 v[8];
#pragma unroll
        for (int j = 0; j < 8; ++j) v[j] = bf16x4_to_f32(nw[j]);
        { const int mn = (m + NWAVES < m1) ? m + NWAVES : m;
#pragma unroll
          for (int j = 0; j < 8; ++j) nw[j] = *(const u32x2*)(u + (size_t)mn * DM + 256 * j + 4 * lane_); }
        ln_inplace(v, g, b, lane_);
        store_row_f32_q(v, XF + (size_t)m * DM, XQ + (size_t)m * DM, SX + m, lane_);
        float lg[8];
#pragma unroll
        for (int e = 0; e < 8; ++e) lg[e] = 0.f;
#pragma unroll
        for (int j = 0; j < 8; ++j)
#pragma unroll
            for (int i = 0; i < 4; ++i) { const int k = 256 * j + 4 * lane_ + i; const f32x4 w0 = *(const LAS f32x4*)(wr + k * 8), w1 = *(const LAS f32x4*)(wr + k * 8 + 4); const float xv = v[j][i];
                lg[0] += xv * w0[0]; lg[1] += xv * w0[1]; lg[2] += xv * w0[2]; lg[3] += xv * w0[3]; lg[4] += xv * w1[0]; lg[5] += xv * w1[1]; lg[6] += xv * w1[2]; lg[7] += xv * w1[3]; }
#pragma unroll
        for (int e = 0; e < 8; ++e) lg[e] = wave_sum(lg[e]);
        float b0 = lg[0]; int e0 = 0;
#pragma unroll
        for (int e = 1; e < 8; ++e) if (lg[e] > b0) { b0 = lg[e]; e0 = e; }
        float b1 = -__builtin_inff(); int e1 = 0;
#pragma unroll
        for (int e = 0; e < 8; ++e) if (e != e0 && lg[e] > b1) { b1 = lg[e]; e1 = e; }
        if (lane_ == 0) { const float g1 = 1.0f / (1.0f + __expf(b0 - b1)), g0 = 1.0f - g1;
            const int r0 = atomicAdd((int*)&lcnt[e0], 1), r1 = atomicAdd((int*)&lcnt[e1], 1);
            tokE[2 * m] = e0; tokE[2 * m + 1] = e1; tokG[2 * m] = g0; tokG[2 * m + 1] = g1;
            LAS int* lr = lcnt + 16 + 4 * (m - m0); lr[0] = e0; lr[1] = e1; lr[2] = r0; lr[3] = r1; }
    }
    __syncthreads();
    if (tid_ < 8) lcnt[8 + tid_] = (int)__hip_atomic_fetch_add(F.ctl + CW_CNT + tid_, (unsigned)lcnt[tid_], RLX_AGENT);
    __syncthreads();
    for (int t = tid_; t < 2 * (m1 - m0); t += NTHREADS) { const LAS int* lr = lcnt + 16 + 4 * (t >> 1); const int e = lr[t & 1]; tokR[2 * m0 + t] = lr[2 + (t & 1)] + lcnt[8 + e]; }
}
__device__ __forceinline__ void moe_layout(Frame& F) {
    const int lane_ = lane_id(), tid_ = F.wave * 64 + lane_; (void)tid_;
    if (tid_ == 0) { unsigned rs = 0, ts = 0;
        for (int e = 0; e < NE; ++e) { const unsigned c = __hip_atomic_load(F.ctl + CW_CNT + e, RLX_AGENT), nt = (c + 255u) >> 8; F.MISC[16 + e] = rs; F.MISC[32 + e] = ts; rs += nt * 256u; ts += nt; }
        F.MISC[16 + NE] = rs; F.MISC[32 + NE] = ts; }
    __syncthreads();
}
__device__ __forceinline__ void gather_phase(Frame& F) {
    const int lane_ = lane_id(), tid_ = F.wave * 64 + lane_; (void)tid_;
    const i8_t* XQ = (const i8_t*)(F.ws + WS_XB); i8_t* XS = (i8_t*)(F.ws + WS_XS); const float* SX = (const float*)(F.ws + WS_SX); float* SXS = (float*)(F.ws + WS_SXS);
    const int* tokE = (const int*)(F.ws + WS_TOKE); const int* tokR = (const int*)(F.ws + WS_TOKR); int* tokP = (int*)(F.ws + WS_TOKP);
    const int gw = F.vcu * NWAVES + F.wave, NGW = F.G * NWAVES;
    int ne0 = 0, ne1 = 0, nr0 = 0, nr1 = 0; float nsc = 0.f; u32x4 nv0 = (u32x4){0u, 0u, 0u, 0u}, nv1 = nv0;
    if (gw < M) { ne0 = tokE[2 * gw]; ne1 = tokE[2 * gw + 1]; nr0 = tokR[2 * gw]; nr1 = tokR[2 * gw + 1]; nsc = SX[gw];
        const u32x4* src = (const u32x4*)(XQ + (size_t)gw * DM); nv0 = src[lane_]; nv1 = src[64 + lane_]; }
    for (int m = gw; m < M; m += NGW) {
        const int e0 = ne0, e1 = ne1, r0 = nr0, r1 = nr1; const float sc = nsc; const u32x4 v0 = nv0, v1 = nv1;
        { const int mn = (m + NGW < M) ? m + NGW : m; ne0 = tokE[2 * mn]; ne1 = tokE[2 * mn + 1]; nr0 = tokR[2 * mn]; nr1 = tokR[2 * mn + 1]; nsc = SX[mn];
          const u32x4* src = (const u32x4*)(XQ + (size_t)mn * DM); nv0 = src[lane_]; nv1 = src[64 + lane_]; }
        const int p0 = (int)F.MISC[16 + e0] + r0, p1 = (int)F.MISC[16 + e1] + r1;
        if (lane_ == 0) { tokP[2 * m] = p0; tokP[2 * m + 1] = p1; SXS[p0] = sc; SXS[p1] = sc; }
        u32x4* d0 = (u32x4*)(XS + (size_t)p0 * DM); u32x4* d1 = (u32x4*)(XS + (size_t)p1 * DM);
        d0[lane_] = v0; d1[lane_] = v0; d0[64 + lane_] = v1; d1[64 + lane_] = v1; }
}
__device__ __forceinline__ void final_phase(Frame& F, const float* g, const float* b, const int mode, const int limit) {
    const int lane_ = lane_id();
    const bf16_t* XF = (const bf16_t*)(F.ws + WS_XF); const bf16_t* OE = (const bf16_t*)(F.ws + WS_OE);
    const float* tokG = (const float*)(F.ws + WS_TOKG); const int* tokP = (const int*)(F.ws + WS_TOKP);
    unsigned* done = F.ctl + CW_DONE;
    const int gw = F.vcu * NWAVES + F.wave, NGW = F.G * NWAVES, s = NGW / 8 + 8;
    for (int k = 0; k * NGW < M; ++k) {
        const int m = (mode == 0 ? gw : (gw + s * k) % NGW) + NGW * k; if (m >= M) continue;
        const int p0 = __builtin_amdgcn_readfirstlane(tokP[2 * m]), p1 = __builtin_amdgcn_readfirstlane(tokP[2 * m + 1]);
        if (mode == 0) { if (p0 >= limit || p1 >= limit) continue; }
        else { if (__builtin_amdgcn_readfirstlane((int)done[m]) != 0) continue; }
        f32x4 v[8];
        const float g0 = tokG[2 * m], g1 = tokG[2 * m + 1];
#pragma unroll
        for (int j = 0; j < 8; ++j) { const int col = 256 * j + 4 * lane_; const f32x4 xv = ld_bf16x4(XF + (size_t)m * DM + col);
            const u32x2 a = *(const u32x2*)(OE + (size_t)p0 * DM + col), c = *(const u32x2*)(OE + (size_t)p1 * DM + col);
            f32x4 fa, fc; fa[0] = __uint_as_float(a.x << 16); fa[1] = __uint_as_float(a.x & 0xffff0000u); fa[2] = __uint_as_float(a.y << 16); fa[3] = __uint_as_float(a.y & 0xffff0000u);
            fc[0] = __uint_as_float(c.x << 16); fc[1] = __uint_as_float(c.x & 0xffff0000u); fc[2] = __uint_as_float(c.y << 16); fc[3] = __uint_as_float(c.y & 0xffff0000u);
            v[j] = xv * ALPHA + fa * g0 + fc * g1; }
        ln_inplace(v, g, b, lane_);
#pragma unroll
        for (int j = 0; j < 8; ++j) *(f32x4*)(F.out + (size_t)m * DM + 256 * j + 4 * lane_) = v[j];
        if (mode == 0 && lane_ == 0) done[m] = 1u;
    }
}
__device__ __forceinline__ void kmean_phase(Frame& F) {
    const int lane_ = lane_id(), tid_ = F.wave * 64 + lane_; (void)tid_;
    const bf16_t* Kh = (const bf16_t*)(F.ws + WS_K); bf16_t* KM = (bf16_t*)(F.ws + WS_KMEAN);
    const int gw = F.vcu * NWAVES + F.wave, NGW = F.G * NWAVES;
    for (int it = gw; it < NB * NH * NBLK; it += NGW) { const u32x4* p = (const u32x4*)(Kh + (size_t)it * 256 * HD) + lane_; float s[8];
#pragma unroll
        for (int k = 0; k < 8; ++k) s[k] = 0.f;
#pragma unroll 16
        for (int r = 0; r < 64; ++r) { const u32x4 w = p[r * 64];
            s[0] += __uint_as_float(w.x << 16); s[1] += __uint_as_float(w.x & 0xffff0000u); s[2] += __uint_as_float(w.y << 16); s[3] += __uint_as_float(w.y & 0xffff0000u);
            s[4] += __uint_as_float(w.z << 16); s[5] += __uint_as_float(w.z & 0xffff0000u); s[6] += __uint_as_float(w.w << 16); s[7] += __uint_as_float(w.w & 0xffff0000u); }
#pragma unroll
        for (int k = 0; k < 8; ++k) { s[k] += __shfl_xor(s[k], 16); s[k] += __shfl_xor(s[k], 32); }
        if (lane_ < 16) { u32x4 o; o.x = cvt_pk_bf16(s[0] * (1.f / 256.f), s[1] * (1.f / 256.f)); o.y = cvt_pk_bf16(s[2] * (1.f / 256.f), s[3] * (1.f / 256.f));
            o.z = cvt_pk_bf16(s[4] * (1.f / 256.f), s[5] * (1.f / 256.f)); o.w = cvt_pk_bf16(s[6] * (1.f / 256.f), s[7] * (1.f / 256.f)); ((u32x4*)(KM + (size_t)it * HD))[lane_] = o; } }
    if (F.vcu == 0 && tid_ == 0) { float* scl = (float*)(F.ws + WS_SCL); const unsigned eb = (__hip_atomic_load(F.ctl + CW_VMAX, RLX_AGENT) >> 23) & 0xffu;
        const float so = (eb < 16u || eb > 240u) ? 1.0f : __uint_as_float((261u - eb) << 23);
        scl[NE + 2] = so; scl[NE + 3] = so * scl[NE + 1]; }
}

struct SchedDense {
    pg8::TileOrder T; const char* A; const char* B; size_t astep, bstep;
    __device__ __forceinline__ bool next(int i, pg8::Unit& u) const { int pm, pn; if (!T.pmpn(i, pm, pn)) return false; u.pm = pm; u.pn = pn; u.aux = 0; u.A = A + (size_t)pm * astep; u.B = B + (size_t)pn * bstep; return true; }
};
struct SchedPool {
    pg8::TileOrder T; const char* A; const char* B;
    __device__ __forceinline__ bool next(int i, pg8::Unit& u) const { int pm, pn; if (!T.pmpn(i, pm, pn)) return false; u.pm = pm; u.pn = pn; u.aux = pn >> 1;
        u.A = A + ((size_t)pm * 256 * DM + (size_t)(pn >> 1) * PGC) * 2; u.B = B + ((size_t)(pn >> 1) * PGC * PGC + (size_t)(pn & 1) * 256 * PGC) * 2; return true; }
};
struct SchedMoe {
    pg8::TileOrder T; const char* A; const char* B; size_t astep, bstep, estep; volatile LAS unsigned* ts; int pm0;
    __device__ __forceinline__ bool next(int i, pg8::Unit& u) const { int pm, pn; if (!T.pmpn(i, pm, pn)) return false; pm += pm0; u.pm = pm; u.pn = pn;
        int e = 0;
#pragma unroll
        for (int k = 1; k < NE; ++k) e += ((unsigned)pm >= (unsigned)__builtin_amdgcn_readfirstlane((int)ts[k])) ? 1 : 0;
        u.aux = e; u.A = A + (size_t)pm * astep; u.B = B + (size_t)e * estep + (size_t)pn * bstep; return true; }
};

struct Args { const float* in[17]; float* out; unsigned char* ws; int ph_lo, ph_hi; };
constexpr int N_PHASES = 16;
__global__ void __launch_bounds__(NTHREADS, 2) fwd_kernel(Args args) {
    extern __shared__ __attribute__((aligned(16))) unsigned char lds[];
    Frame F;
    F.lds = (LAS unsigned char*)lds;
    F.MISC = (volatile LAS unsigned*)(F.lds + MISC_OFF);
    F.wave = __builtin_amdgcn_readfirstlane((int)(threadIdx.x >> 6));
    const int lane_ = lane_id(), tid_ = F.wave * 64 + lane_;
    F.G = gridDim.x; { const int bx = blockIdx.x; F.vcu = (F.G % 8 == 0) ? (bx % 8) * (F.G / 8) + bx / 8 : bx; }
    F.ws = args.ws; F.ctl = (unsigned*)(args.ws + WS_CTL);
    F.out = args.out;
    for (int u = tid_; u < (LDS_BYTES - LDSCTL_OFF) / 4; u += NTHREADS) ((LAS unsigned*)(F.lds + LDSCTL_OFF))[u] = 0u;
    if (tid_ < 17) { const unsigned long long pv = (unsigned long long)args.in[tid_]; F.MISC[64 + 2 * tid_] = (unsigned)pv; F.MISC[64 + 2 * tid_ + 1] = (unsigned)(pv >> 32); }
    __syncthreads();
    XcdBarrier bar; bar.bar = F.ctl + CW_BAR; bar.x = 0; bar.st = nullptr;
    if (MK_N_LAUNCHES == 1) bar = xcd_barrier_post(F.ctl + CW_BAR, F.MISC + 8, tid_ == 0);
    const int lo = args.ph_lo, hi = args.ph_hi;
#define IN(k) (lo <= (k) && (k) < hi)
#define REPS(k) for (int rep_ = 0; rep_ < ((PROBE_DUP == (k)) ? 2 : 1); ++rep_)
#define SEAM(k) do { if (IN(k) && IN((k) + 1)) xcd_barrier(bar, F.wave); } while (0)
    unsigned char* ws = args.ws;
    const char* XQ = (const char*)(ws + WS_XB); const bf16_t* XF = (const bf16_t*)(ws + WS_XF); bf16_t* U = (bf16_t*)args.out; const float* SX = (const float*)(ws + WS_SX);
    const int cid = (int)blockIdx.x;

    if (IN(0)) REPS(0) {
        convert_family(F, F.in(I_POOLW), PGC, PGC, (size_t)PGC * PGC, (bf16_t*)(ws + WS_WPOOL), (size_t)PGC * PGC, 4);
        down_scale_sample(F);
        __syncthreads();
        quant_weights(F);
        rope_tables(F);
        pool_diff(F);
    }
    SEAM(0);
    if (IN(1)) REPS(1) {
        SchedPool S; S.T.init(M / 256, DM / 256, F.G, cid); S.A = (const char*)(ws + WS_DIFF); S.B = (const char*)(ws + WS_WPOOL);
        pg8::EpiRes<true> E{(const void*)F.in(I_X), U, DM, F.in(I_POOLS), nullptr};
        pg8::gemm_phase<0, pg8::EpiRes<true>, SchedPool, true>(F.lds + RING_OFF, pg8::GemmP{PGC / 64, DM * 2, PGC * 2}, S, E, F.wave);
    }
    SEAM(1);
    if (IN(2)) REPS(2) { ln_phase(F, U, F.in(I_LMG), F.in(I_LMB)); __syncthreads();
        down_quant(F, F.lds + RING_OFF, F.in(I_FD), DFF, 1, (const float*)(ws + WS_SCL) + NE, ws + WS_WD, 0, ((DFF / 512) * (DM / 64) + F.G - 1) / F.G);
        down_quant(F, F.lds + RING_OFF, F.in(I_WO), DM, 1, (const float*)(ws + WS_SCL) + NE + 1, ws + WS_WO, 0, ((DM / 512) * (DM / 64) + F.G - 1) / F.G); }
    SEAM(2);
    if (IN(3)) REPS(3) {
        SchedDense S; S.T.init(M / 256, 2 * DFF / 256, F.G, cid); S.A = XQ; S.B = (const char*)(ws + WS_WGU); S.astep = (size_t)256 * DM; S.bstep = (size_t)256 * DM;
        pg8::EpiSwiGLU<true> E{(void*)(ws + WS_HFFN), DFF, SX, (const float*)(ws + WS_SWGU), 0};
        pg8::gemm_phase<1, pg8::EpiSwiGLU<true>, SchedDense, true>(F.lds + RING_OFF, pg8::GemmP{DM / 128, DM, DM}, S, E, F.wave);
    }
    SEAM(3);
    if (IN(4)) REPS(4) {
        SchedDense S; S.T.init(M / 256, DM / 256, F.G, cid, WGM_BIGK); S.A = (const char*)(ws + WS_HFFN); S.B = (const char*)(ws + WS_WD); S.astep = (size_t)256 * DFF; S.bstep = (size_t)256 * DFF;
        pg8::EpiRes<false> E{(const void*)XF, U, DM, nullptr, (const float*)(ws + WS_SCL) + NE};
        pg8::gemm_phase<2, pg8::EpiRes<false>, SchedDense, true>(F.lds + RING_OFF, pg8::GemmP{DFF / 128, DFF, DFF}, S, E, F.wave);
    }
    SEAM(4);
    if (IN(5)) REPS(5) ln_phase(F, U, F.in(I_LFG), F.in(I_LFB));
    SEAM(5);
    if (IN(6)) REPS(6) {
        SchedDense S; S.T.init(M / 256, 3 * DM / 256, F.G, cid); S.A = XQ; S.B = (const char*)(ws + WS_WQKV); S.astep = (size_t)256 * DM; S.bstep = (size_t)256 * DM;
        pg8::EpiQKV E{(bf16_t*)(ws + WS_Q), (bf16_t*)(ws + WS_K), (bf16_t*)(ws + WS_V), (const float*)(ws + WS_COS), (const float*)(ws + WS_SIN), SX, (const float*)(ws + WS_SWQKV), F.ctl + CW_VMAX};
        pg8::gemm_phase<1, pg8::EpiQKV, SchedDense, true>(F.lds + RING_OFF, pg8::GemmP{DM / 128, DM, DM}, S, E, F.wave);
    }
    SEAM(6);
    if (IN(7)) REPS(7) kmean_phase(F);
    SEAM(7);
    if (IN(8)) REPS(8) {
        struct MoeSide { Frame& F; __device__ __forceinline__ void operator()(int slot, int nslots) const { moe_side_work(F, slot, nslots); } };
        att::attn_phase((char*)lds + RING_OFF, ws, F.G, F.vcu, F.wave, MoeSide{F});
    }
    SEAM(8);
    if (IN(9)) REPS(9) {
        SchedDense S; S.T.init(M / 256, DM / 256, F.G, cid); S.A = (const char*)(ws + WS_O); S.B = (const char*)(ws + WS_WO); S.astep = (size_t)256 * DM; S.bstep = (size_t)256 * DM;
        pg8::EpiRes<false> E{(const void*)XF, U, DM, nullptr, (const float*)(ws + WS_SCL) + NE + 3};
        pg8::gemm_phase<2, pg8::EpiRes<false>, SchedDense, true>(F.lds + RING_OFF, pg8::GemmP{DM / 128, DM, DM}, S, E, F.wave);
    }
    SEAM(9);
    if (IN(10)) ln_router_phase(F, U, F.in(I_LMG) + DM, F.in(I_LMB) + DM);
    SEAM(10);
    if (IN(11)) REPS(11) { moe_layout(F); gather_phase(F); }
    SEAM(11);
    if (IN(12)) REPS(12) {
        moe_layout(F);
        SchedMoe S; S.T.init(__builtin_amdgcn_readfirstlane((int)F.MISC[32 + NE]), 2 * DFE / 256, F.G, cid); S.A = (const char*)(ws + WS_XS); S.B = (const char*)(ws + WS_MWGU);
        S.astep = (size_t)256 * DM; S.bstep = (size_t)256 * DM; S.estep = (size_t)2 * DFE * DM; S.ts = F.MISC + 32; S.pm0 = 0;
        pg8::EpiSwiGLU<true> E{(void*)(ws + WS_HMOE), DFE, (const float*)(ws + WS_SXS), (const float*)(ws + WS_SWM), 2 * DFE};
        pg8::gemm_phase<1, pg8::EpiSwiGLU<true>, SchedMoe, true>(F.lds + RING_OFF, pg8::GemmP{DM / 128, DM, DM}, S, E, F.wave);
    }
    SEAM(12);
    if (IN(13)) REPS(13) {
        moe_layout(F);
        const int nRT = __builtin_amdgcn_readfirstlane((int)F.MISC[32 + NE]), nRTa = (nRT / (F.G / 8)) * (F.G / 8);
        SchedMoe S; S.T.init(nRTa, DM / 256, F.G, cid, WGM_BIGK); S.A = (const char*)(ws + WS_HMOE); S.B = (const char*)(ws + WS_MWD);
        S.astep = (size_t)256 * DFE; S.bstep = (size_t)256 * DFE; S.estep = (size_t)DM * DFE; S.ts = F.MISC + 32; S.pm0 = 0;
        pg8::EpiBf16 E{(bf16_t*)(ws + WS_OE), DM, (const float*)(ws + WS_SCL)};
        pg8::gemm_phase<2, pg8::EpiBf16, SchedMoe, true>(F.lds + RING_OFF, pg8::GemmP{DFE / 128, DFE, DFE}, S, E, F.wave);
    }
    SEAM(13);
    if (IN(14)) REPS(14) {
        moe_layout(F);
        const int nRT = __builtin_amdgcn_readfirstlane((int)F.MISC[32 + NE]), nRTa = (nRT / (F.G / 8)) * (F.G / 8);
        if (cid < (nRT - nRTa) * (DM / 256)) {
            SchedMoe S; S.T.init(nRT - nRTa, DM / 256, F.G, cid, WGM_BIGK); S.A = (const char*)(ws + WS_HMOE); S.B = (const char*)(ws + WS_MWD);
            S.astep = (size_t)256 * DFE; S.bstep = (size_t)256 * DFE; S.estep = (size_t)DM * DFE; S.ts = F.MISC + 32; S.pm0 = nRTa;
            pg8::EpiBf16 E{(bf16_t*)(ws + WS_OE), DM, (const float*)(ws + WS_SCL)};
            pg8::gemm_phase<2, pg8::EpiBf16, SchedMoe, true>(F.lds + RING_OFF, pg8::GemmP{DFE / 128, DFE, DFE}, S, E, F.wave);
        } else final_phase(F, F.in(I_LFG) + DM, F.in(I_LFB) + DM, 0, nRTa * 256);
    }
    SEAM(14);
    if (IN(15)) REPS(15) final_phase(F, F.in(I_LFG) + DM, F.in(I_LFB) + DM, 1, 0);
#undef IN
#undef SEAM
}

extern "C" void kernel_launch(void* const* d_in, const int* in_sizes, int n_in, void* d_out, int out_size, void* d_ws, size_t ws_size, hipStream_t stream) {
    static int grid = 0;
    if (grid == 0) {
        if (n_in != 17 || in_sizes[0] != M * DM || out_size != M * DM || ws_size < WS_END) { fprintf(stderr, "kernel_launch: unexpected shapes (n_in %d, in0 %d, out %d, ws %zu); nothing launched\n", n_in, n_in > 0 ? in_sizes[0] : -1, out_size, ws_size); grid = -1; return; }
        int dev = 0, cus = 0, per_cu = 0;
        if (hipGetDevice(&dev) != hipSuccess || hipDeviceGetAttribute(&cus, hipDeviceAttributeMultiprocessorCount, dev) != hipSuccess) { grid = -1; return; }
        if (hipFuncSetAttribute((const void*)fwd_kernel, hipFuncAttributeMaxDynamicSharedMemorySize, LDS_BYTES) != hipSuccess) { fprintf(stderr, "kernel_launch: hipFuncSetAttribute failed\n"); grid = -1; return; }
        if (hipOccupancyMaxActiveBlocksPerMultiprocessor(&per_cu, (const void*)fwd_kernel, NTHREADS, LDS_BYTES) != hipSuccess || per_cu < 1) { fprintf(stderr, "kernel_launch: occupancy query says %d blocks per CU\n", per_cu); (void)hipGetLastError(); }
        grid = cus;
    }
    if (grid < 0) return;
    (void)hipMemsetAsync((char*)d_ws + WS_CTL, 0, CTL_ZERO_BYTES, stream);
    Args a{};
    for (int i = 0; i < 17; ++i) a.in[i] = (const float*)d_in[i];
    a.out = (float*)d_out; a.ws = (unsigned char*)d_ws;
#if MK_N_LAUNCHES == 1
    a.ph_lo = 0; a.ph_hi = N_PHASES;
    hipLaunchKernelGGL(fwd_kernel, dim3(grid), dim3(NTHREADS), LDS_BYTES, stream, a);
    if (PROBE_RELAUNCH >= 0) { a.ph_lo = PROBE_RELAUNCH; a.ph_hi = PROBE_RELAUNCH + 1; hipLaunchKernelGGL(fwd_kernel, dim3(grid), dim3(NTHREADS), LDS_BYTES, stream, a); }
#else
    for (int p = 0; p < N_PHASES; ++p) { a.ph_lo = p; a.ph_hi = p + 1; hipLaunchKernelGGL(fwd_kernel, dim3(grid), dim3(NTHREADS), LDS_BYTES, stream, a); }
#endif
}
```
